# Optimizing an MI355X kernel written in HIP

```python
import jax, jax.numpy as jnp
from jax import lax
import numpy as np


D_MODEL = 2048
BATCH = 8
SEQ = 2048
DEPTH = 1

MIX_WIDTH = D_MODEL
GROUP_DIM = 128
FOURIER_WIDTH = MIX_WIDTH // 2
GMLP_WIDTH = MIX_WIDTH - FOURIER_WIDTH
N_FOURIER_GROUPS = FOURIER_WIDTH // GROUP_DIM
N_GMLP_HEADS = GMLP_WIDTH // GROUP_DIM
IN_PROJ_WIDTH = FOURIER_WIDTH + 2 * GMLP_WIDTH
CHUNK = 128
D_FF = 4 * D_MODEL
EPS = 1e-6

kernel_name = "hybrid_fourier_gmlp_encoder_block"


def rmsnorm(x, g):
    xf = x.astype(jnp.float32)
    y = xf * lax.rsqrt(jnp.mean(xf * xf, axis=-1, keepdims=True) + EPS)
    return (y * g.astype(jnp.float32)).astype(x.dtype)


def fourier_groups(a, w_f):
    B, S, _ = a.shape
    a4 = a.reshape(B, S, N_FOURIER_GROUPS, GROUP_DIM).astype(jnp.float32)
    f = jnp.real(jnp.fft.fft2(a4, axes=(1, 3), norm="ortho")).astype(a.dtype)
    y = jnp.einsum('bsgc,gcd->bsgd', f, w_f)
    return y.reshape(B, S, FOURIER_WIDTH)


def gmlp_groups(z, g_v, w_s, b_s):
    B, S, _ = z.shape
    z = jax.nn.gelu(z, approximate=False)
    u, v = z[..., :GMLP_WIDTH], z[..., GMLP_WIDTH:]
    v = rmsnorm(v.reshape(B, S, N_GMLP_HEADS, GROUP_DIM), g_v)
    v = v.reshape(B, S // CHUNK, CHUNK, N_GMLP_HEADS, GROUP_DIM)
    s = jnp.einsum('hpq,bnqhd->bnphd', w_s, v) + b_s.T[None, None, :, :, None]
    return u * s.reshape(B, S, GMLP_WIDTH)


def setup_inputs(seed: int = 0) -> dict:
    key = jax.random.key(seed)
    ks = jax.random.split(key, 14)
    f32 = jnp.float32
    x = jax.random.normal(ks[0], (BATCH, SEQ, D_MODEL), f32)
    norm_mix_g = 1.0 + 0.05 * jax.random.normal(ks[1], (D_MODEL,), f32)
    w_in = jax.random.normal(ks[2], (D_MODEL, IN_PROJ_WIDTH), f32) * D_MODEL ** -0.5
    fourier_w = jax.random.normal(ks[3], (N_FOURIER_GROUPS, GROUP_DIM, GROUP_DIM), f32) * GROUP_DIM ** -0.5
    gmlp_v_g = 1.0 + 0.05 * jax.random.normal(ks[4], (N_GMLP_HEADS, GROUP_DIM), f32)
    gmlp_ws = jax.random.normal(ks[5], (N_GMLP_HEADS, CHUNK, CHUNK), f32) * CHUNK ** -0.5
    gmlp_b = 1.0 + 0.01 * jax.random.normal(ks[6], (N_GMLP_HEADS, CHUNK), f32)
    w_out = jax.random.normal(ks[7], (MIX_WIDTH, D_MODEL), f32) * MIX_WIDTH ** -0.5
    norm_mlp_g = 1.0 + 0.05 * jax.random.normal(ks[8], (D_MODEL,), f32)
    w_up = jax.random.normal(ks[9], (D_MODEL, D_FF), f32) * D_MODEL ** -0.5
    w_down = jax.random.normal(ks[10], (D_FF, D_MODEL), f32) * D_FF ** -0.5
    norm_final_g = 1.0 + 0.05 * jax.random.normal(ks[11], (D_MODEL,), f32)
    return {"x": x, "norm_mix_g": norm_mix_g, "w_in": w_in, "fourier_w": fourier_w,
            "gmlp_v_g": gmlp_v_g, "gmlp_ws": gmlp_ws, "gmlp_b": gmlp_b, "w_out": w_out,
            "norm_mlp_g": norm_mlp_g, "w_up": w_up, "w_down": w_down,
            "norm_final_g": norm_final_g}


def reference(x, norm_mix_g, w_in, fourier_w, gmlp_v_g, gmlp_ws, gmlp_b, w_out,
              norm_mlp_g, w_up, w_down, norm_final_g):
    h = x
    for _ in range(DEPTH):
        p = jnp.einsum('bsd,de->bse', rmsnorm(h, norm_mix_g), w_in)
        y_f = fourier_groups(p[..., :FOURIER_WIDTH], fourier_w)
        y_g = gmlp_groups(p[..., FOURIER_WIDTH:], gmlp_v_g, gmlp_ws, gmlp_b)
        mix = jnp.concatenate([y_f, y_g], axis=-1)
        h = h + jnp.einsum('bse,ed->bsd', mix, w_out)
        a = jnp.einsum('bsd,df->bsf', rmsnorm(h, norm_mlp_g), w_up)
        h = h + jnp.einsum('bsf,fd->bsd', jnp.square(jax.nn.relu(a)), w_down)
    return rmsnorm(h, norm_final_g)
```

```cpp
#include <hip/hip_runtime.h>
#include <hip/hip_cooperative_groups.h>
#include <cstdio>
#include <cstdint>
namespace cg = cooperative_groups;

#define LAS __attribute__((address_space(3)))
#define GAS __attribute__((address_space(1)))
typedef unsigned short bf16_t;
typedef short bf16x8 __attribute__((ext_vector_type(8)));
typedef float f32x4 __attribute__((ext_vector_type(4)));
typedef float f32x2 __attribute__((ext_vector_type(2)));
typedef unsigned u32x4 __attribute__((ext_vector_type(4)));

constexpr int DM = 2048, SEQ = 2048, NB = 8, MT = NB * SEQ;
constexpr int FW = 1024, NIN = 3072, DFF = 8192;
constexpr float EPS = 1e-6f;

constexpr size_t MiB = 1u << 20;
constexpr size_t WS_RSX = 0, WS_SSH = 64 * 1024, WS_SSH2 = 128 * 1024;
constexpr size_t WS_BAR = 256 * 1024;
constexpr size_t WS_PCNT = 320 * 1024;
constexpr size_t WS_IGMIX = 384 * 1024, WS_IGMLP = 400 * 1024;
constexpr size_t WS_YA = 576 * 1024;
constexpr size_t WS_Y1024 = 512 * 1024;
constexpr size_t WS_GT = 1 * MiB;
constexpr size_t WS_WIN = 2 * MiB;
constexpr size_t WS_WOUT = 14 * MiB;
constexpr size_t WS_WUP = 22 * MiB;
constexpr size_t WS_WDN = 54 * MiB;
constexpr size_t WS_DFT = 86 * MiB;
constexpr size_t WS_XG = 102 * MiB;
constexpr size_t WS_PF = 166 * MiB;
constexpr size_t WS_U = 198 * MiB;
constexpr size_t WS_VT = 230 * MiB;
constexpr size_t WS_B12 = 262 * MiB;
constexpr size_t WS_MIX = 326 * MiB;
constexpr size_t WS_ACT = 166 * MiB;
constexpr size_t WS_END = 422 * MiB;

constexpr int BM = 256, BK = 64, HALF = 128, HTB = HALF * BK * 2, STAGE_BYTES = 8 * HTB, NXCD = 8, WGM = 8;
constexpr int LDS_BYTES = 147456;

__host__ __device__ __forceinline__ int lds_byte(int r, int c) { const int st = (r >> 4) * 2 + (c >> 5), rr = r & 15, cc = c & 31, ob = rr * 64 + cc * 2; return st * 1024 + (ob ^ (((ob >> 9) & 1) << 5)); }
__host__ __device__ __forceinline__ void stage_rc(int b, int& R, int& C) { const int st = b / 1024, sb = b % 1024, swz = sb ^ (((sb >> 9) & 1) << 5); R = (st >> 1) * 16 + swz / 64; C = (st & 1) * 32 + (swz % 64) / 2; }
__host__ __device__ __forceinline__ int perm32(int rho) { const int n = rho >> 4, i = rho & 15; return 8 * (i >> 2) + 4 * n + (i & 3); }

struct Unit { int pm, pn, ty; };
struct Gemm { int lda, ldb, K; int ksA = BK * 2, ksB = BK * 2; };

struct StaticOrder {
    int nM, nN, nwg, G, c;
    __device__ void init(int M, int N, int G_, int c_) { nM = M / BM; nN = N / BM; nwg = nM * nN; G = G_; c = c_; }
    __device__ bool next(int i, Unit& u) const {
        const long L = (long)i * G + c; if (L >= nwg) return false;
        int wgid = (int)L; { const int q = nwg / NXCD, r = nwg % NXCD, xcd = wgid % NXCD, off = wgid / NXCD; wgid = (xcd < r ? xcd * (q + 1) : r * (q + 1) + (xcd - r) * q) + off; }
        const int nig = WGM * nN, gid = wgid / nig, fm = gid * WGM, gsz = (nM - fm) < WGM ? (nM - fm) : WGM;
        u.pm = fm + ((wgid % nig) % gsz); u.pn = (wgid % nig) / gsz; u.ty = 0; return true;
    }
};

__device__ __forceinline__ unsigned cvt_pk_bf16(float lo, float hi) { unsigned r; asm volatile("v_cvt_pk_bf16_f32 %0, %1, %2" : "=v"(r) : "v"(lo), "v"(hi)); return r; }
__device__ __forceinline__ float bf2f(unsigned short b) { return __builtin_bit_cast(float, ((unsigned)b) << 16); }
__device__ __forceinline__ f32x2 gelu_pk(f32x2 v) {
    const f32x2 av = __builtin_elementwise_abs(v), d = av * 0.2316418882f + 1.0f;
    f32x2 t; t.x = __builtin_amdgcn_rcpf(d.x); t.y = __builtin_amdgcn_rcpf(d.y);
    f32x2 q = t * 0.5307027145f + (-0.7265760135f); q = q * t + 0.7107068705f; q = q * t + (-0.142248368f); q = q * t + 0.127414796f; q = q * t;
    const f32x2 s = (v * v) * (-0.72134752044f);
    f32x2 e; e.x = __builtin_amdgcn_exp2f(s.x); e.y = __builtin_amdgcn_exp2f(s.y);
    const f32x2 m = v * (q * e), r = v - m;
    f32x2 o; o.x = v.x < 0.f ? m.x : r.x; o.y = v.y < 0.f ? m.y : r.y; return o;
}
__device__ __forceinline__ f32x4 gelu4(f32x4 v) { f32x2 a = gelu_pk((f32x2){v[0], v[1]}), b = gelu_pk((f32x2){v[2], v[3]}); return (f32x4){a.x, a.y, b.x, b.y}; }
__device__ __forceinline__ u32x4 pack8(f32x4 v0, f32x4 v1) { u32x4 w; w.x = cvt_pk_bf16(v0[0], v0[1]); w.y = cvt_pk_bf16(v0[2], v0[3]); w.z = cvt_pk_bf16(v1[0], v1[1]); w.w = cvt_pk_bf16(v1[2], v1[3]); return w; }

__device__ __forceinline__ int lane_id() { int l; asm volatile("v_mbcnt_lo_u32_b32 %0, -1, 0\n\tv_mbcnt_hi_u32_b32 %0, -1, %0" : "=v"(l)); return l; }
#define XB_TMO      128
#define XB_XCNT(j)  (256  + 64 * (j))
#define XB_XSUB(j)  (1280 + 64 * (j))
#define XB_XGEN(j)  (2304 + 64 * (j))
#define XB_TOP      3328
#define XB_TOPGEN   3392
#define XCD_BAR_WORDS 3456
#define XB_SPIN_CAP (1u << 20)
__device__ __forceinline__ unsigned xb_ld(unsigned* p)              { return __hip_atomic_load(p, __ATOMIC_RELAXED, __HIP_MEMORY_SCOPE_AGENT); }
__device__ __forceinline__ unsigned xb_add(unsigned* p, unsigned v) { return __hip_atomic_fetch_add(p, v, __ATOMIC_RELAXED, __HIP_MEMORY_SCOPE_AGENT); }
__device__ __forceinline__ unsigned xb_xcc_id() { return (unsigned)__builtin_amdgcn_s_getreg((3 << 11) | 20) & 0xFu; }
#define XB_SPIN(cond, bar) do { unsigned _sp = 0; while (cond) { __builtin_amdgcn_s_sleep(1); \
    if ((++_sp & 255u) == 0u) { if (xb_ld(&(bar)[XB_TMO])) break; if (_sp > XB_SPIN_CAP) { atomicAdd(&(bar)[XB_TMO], 1u); break; } } } } while (0)
__device__ __forceinline__ void xcd_barrier_complete(unsigned* bar, unsigned x, unsigned G, unsigned& nloc, unsigned& nx) {
    unsigned sum, cnt, mine, sp = 0u;
    for (;;) {
        sum = 0u; cnt = 0u; mine = 0u;
#pragma unroll
        for (unsigned j = 0; j < 16; ++j) { const unsigned c = xb_ld(&bar[XB_XCNT(j)]); sum += c; cnt += (c > 0u) ? 1u : 0u; mine = (j == x) ? c : mine; }
        if (sum == G) break;
        __builtin_amdgcn_s_sleep(1);
        if ((++sp & 255u) == 0u) { if (xb_ld(&bar[XB_TMO])) break; if (sp > XB_SPIN_CAP) { atomicAdd(&bar[XB_TMO], 1u); break; } }
    }
    nloc = mine > 0u ? mine : 1u; nx = cnt > 0u ? cnt : 1u;
}
__device__ __forceinline__ void xcd_barrier(unsigned* bar, unsigned x, volatile LAS unsigned* st, unsigned G, int tid) {
    asm volatile("s_waitcnt vmcnt(0)" ::: "memory");
    __syncthreads();
    if (tid == 0) {
        __builtin_amdgcn_s_waitcnt(0);
        unsigned nloc = st[0], nx = st[1];
        if (nloc == 0u) { xcd_barrier_complete(bar, x, G, nloc, nx); st[0] = nloc; st[1] = nx; }
        const unsigned old = xb_add(&bar[XB_XSUB(x)], 1u);
        const unsigned gen = old / nloc;
        if (old + 1u == (gen + 1u) * nloc) {
            __builtin_amdgcn_fence(__ATOMIC_RELEASE, "agent");
            asm volatile("s_waitcnt vmcnt(0)" ::: "memory");
            const unsigned og = xb_add(&bar[XB_TOP], 1u);
            const unsigned tg = og / nx;
            if (og + 1u == (tg + 1u) * nx) xb_add(&bar[XB_TOPGEN], 1u);
            else XB_SPIN(xb_ld(&bar[XB_TOPGEN]) == tg, bar);
            __builtin_amdgcn_fence(__ATOMIC_ACQUIRE, "agent");
            xb_add(&bar[XB_XGEN(x)], 1u);
            asm volatile("s_waitcnt vmcnt(0)" ::: "memory");
        } else {
            XB_SPIN(xb_ld(&bar[XB_XGEN(x)]) == gen, bar);
            __builtin_amdgcn_fence(__ATOMIC_ACQUIRE, "agent");
            asm volatile("s_waitcnt vmcnt(0)" ::: "memory");
        }
    }
    __syncthreads();
}

struct SchedStd {
    StaticOrder so; const char* A; const char* B; size_t ta, tb;
    __device__ __forceinline__ bool next(int i, Unit& u) const { return so.next(i, u); }
    __device__ __forceinline__ void ptrs(const Unit& u, const char*& a, const char*& b) const { a = A + (size_t)u.pm * ta; b = B + (size_t)u.pn * tb; }
};
struct SchedIn {
    int c; const char* XG; const char* W;
    __device__ __forceinline__ bool next(int i, Unit& u) const { if (i >= 3) return false; const int x = c & 7, j = c >> 3, jj = j & 7, ct = j >> 3; u.pn = ct;
        if (jj < 4) { u.pm = 8 * x + jj + (i == 1 ? 4 : 0); u.ty = i == 0 ? 0 : (i == 1 ? 3 : 1); }
        else        { u.pm = 8 * x + jj - (i == 2 ? 4 : 0); u.ty = i == 0 ? 1 : 2; }
        return true; }
    __device__ __forceinline__ void ptrs(const Unit& u, const char*& a, const char*& b) const {
        const int wt = (u.ty == 1 ? 4 : (u.ty == 2 ? 8 : 0)) + u.pn;
        const char* xa = XG + (size_t)u.pm * (size_t)(256 * DM * 2); const char* wb = W + (size_t)wt * (size_t)(256 * DM * 2);
        if (u.ty == 1) { a = xa; b = wb; } else { a = wb; b = xa; }
    }
};
typedef f32x4 Acc[2][2][4][2];

struct EpiIn {
    static constexpr bool PERM = true;
    bf16_t* AT; bf16_t* U; bf16_t* VT; const float* rstd; float* ya;
    __device__ __forceinline__ void operator()(const Acc& acc, const Unit& u, int wr, int wc, int fr_, int fq_) const {
        int fr = fr_, fq = fq_; asm volatile("" : "+v"(fr), "+v"(fq));
        if (u.ty == 1) {
            const int row0 = u.pm * BM + wr * 64 + fr, col0 = u.pn * BM + wc * 32 + 8 * fq;
#pragma unroll
            for (int ai = 0; ai < 2; ++ai)
#pragma unroll
                for (int m = 0; m < 4; ++m) { const int r = row0 + ai * HALF + m * 16; const float rs = rstd[r]; bf16_t* rowp = U + (size_t)r * FW + col0;
#pragma unroll
                    for (int bj = 0; bj < 2; ++bj) { f32x4 v0 = gelu4(acc[ai][bj][m][0] * rs), v1 = gelu4(acc[ai][bj][m][1] * rs);
                        *(u32x4*)(rowp + bj * HALF) = pack8(v0, v1); } }
        } else {
            const int col0 = u.pm * BM + wc * 32 + 8 * fq;
            f32x4 rs[2][2];
#pragma unroll
            for (int bj = 0; bj < 2; ++bj)
#pragma unroll
                for (int n = 0; n < 2; ++n) rs[bj][n] = *(const f32x4*)(rstd + col0 + bj * HALF + 4 * n);
            if (u.ty == 2) {
#pragma unroll
                for (int ai = 0; ai < 2; ++ai)
#pragma unroll
                    for (int m = 0; m < 4; ++m) { const int hh = u.pn * 2 + ai, dd = wr * 64 + m * 16 + fr;
                        const int r5 = dd & 31, frag = (((wc * 4 + (dd >> 5)) * 2 + ((r5 >> 2) & 1)) * 64 + fq * 16 + (r5 >> 3) * 4 + (r5 & 3)) * 8;
#pragma unroll
                        for (int bj = 0; bj < 2; ++bj) { f32x4 v0 = gelu4(acc[ai][bj][m][0] * rs[bj][0]), v1 = gelu4(acc[ai][bj][m][1] * rs[bj][1]);
                            *(u32x4*)(VT + (size_t)((u.pm * 2 + bj) * 8 + hh) * 16384 + frag) = pack8(v0, v1); } }
            } else {
                const int b = u.pm >> 3, s0 = (u.pm & 7) * BM + wc * 32 + 8 * fq;
#pragma unroll
                for (int ai = 0; ai < 2; ++ai) {
                    u32x4 pw[4][2];
                    if (u.ty == 3) {
#pragma unroll
                        for (int m = 0; m < 4; ++m)
#pragma unroll
                            for (int bj = 0; bj < 2; ++bj) pw[m][bj] = *(const u32x4*)(AT + (size_t)((b * 8 + u.pn * 2 + ai) * 128 + wr * 64 + m * 16 + fr) * SEQ + s0 - 1024 + bj * HALF);
                        asm volatile("" ::: "memory");
                    }
#pragma unroll
                    for (int m = 0; m < 4; ++m) { const int n = (b * 8 + u.pn * 2 + ai) * 128 + wr * 64 + m * 16 + fr; bf16_t* rowp = AT + (size_t)n * SEQ + s0; float t = 0.f;
#pragma unroll
                        for (int bj = 0; bj < 2; ++bj) { const f32x4 a0 = acc[ai][bj][m][0] * rs[bj][0], a1 = acc[ai][bj][m][1] * rs[bj][1];
                            t += ((a0[0] - a0[1]) + (a0[2] - a0[3])) + ((a1[0] - a1[1]) + (a1[2] - a1[3]));
                            if (u.ty == 0) *(u32x4*)(rowp + bj * HALF) = pack8(a0, a1);
                            else { f32x4 p0, p1;
                                p0[0] = __builtin_bit_cast(float, pw[m][bj].x << 16); p0[1] = __builtin_bit_cast(float, pw[m][bj].x & 0xffff0000u); p0[2] = __builtin_bit_cast(float, pw[m][bj].y << 16); p0[3] = __builtin_bit_cast(float, pw[m][bj].y & 0xffff0000u);
                                p1[0] = __builtin_bit_cast(float, pw[m][bj].z << 16); p1[1] = __builtin_bit_cast(float, pw[m][bj].z & 0xffff0000u); p1[2] = __builtin_bit_cast(float, pw[m][bj].w << 16); p1[3] = __builtin_bit_cast(float, pw[m][bj].w & 0xffff0000u);
                                *(u32x4*)(rowp - 1024 + bj * HALF) = pack8(p0 + a0, p1 + a1);
                                *(u32x4*)(rowp + bj * HALF) = pack8(p0 - a0, p1 - a1); } }
                        t += __shfl_xor(t, 16); t += __shfl_xor(t, 32);
                        if (fq == 0) unsafeAtomicAdd(ya + n, t); }
                    asm volatile("" ::: "memory");
                }
            }
        }
    }
};
struct SchedPair {
    int w, NW; const char* D; const char* B;
    __device__ __forceinline__ bool next(int i, Unit& u) const { const int pi = w + (i >> 1) * NW; if (pi >= 128) return false; const int x = pi & 7, j = pi >> 3; u.pm = j & 3; u.pn = x * 4 + (j >> 2); u.ty = i & 1; return true; }
    __device__ __forceinline__ void ptrs(const Unit& u, const char*& a, const char*& b) const { a = D + (size_t)u.pm * (256 * 2048 * 2) + u.ty * 2048; b = B + (size_t)u.pn * (256 * 2048 * 2) + (u.pm >> 1) * 2048; }
};
struct EpiDftZ {
    static constexpr bool PERM = true;
    bf16_t* Z;
    __device__ __forceinline__ void operator()(const Acc& acc, const Unit& u, int wr, int wc, int fr_, int fq_) const {
        int fr = fr_, fq = fq_; asm volatile("" : "+v"(fr), "+v"(fq));
        bf16_t* zb = Z + (size_t)(u.pn * 4 + u.pm) * (2 * 256 * 256) + u.ty * 128 + wc * 32 + 8 * fq;
#pragma unroll
        for (int ai = 0; ai < 2; ++ai)
#pragma unroll
            for (int m = 0; m < 4; ++m) { const int r = ai * HALF + wr * 64 + m * 16 + fr;
#pragma unroll
                for (int bj = 0; bj < 2; ++bj) *(u32x4*)(zb + (size_t)(bj * 256 + r) * 256) = pack8(acc[ai][bj][m][0], acc[ai][bj][m][1]); }
    }
};
struct SchedPost {
    int w, NW; const char* Z; const char* GP;
    __device__ __forceinline__ bool next(int i, Unit& u) const { const int pi = w + (i >> 1) * NW; if (pi >= 128) return false; const int x = pi & 7, j = pi >> 3; u.pm = j & 3; u.pn = x * 4 + (j >> 2); u.ty = i & 1; return true; }
    __device__ __forceinline__ void ptrs(const Unit& u, const char*& a, const char*& b) const { a = Z + (size_t)((u.pn * 4 + u.pm) * 2 + u.ty) * (256 * 256 * 2); b = GP + (size_t)((u.pn & 3) * 2 + u.ty) * (256 * 256 * 2); }
};
struct EpiPost {
    static constexpr bool PERM = true;
    bf16_t* MIX;
    __device__ __forceinline__ void operator()(const Acc& acc, const Unit& u, int wr, int wc, int fr_, int fq_) const {
        int fr = fr_, fq = fq_; asm volatile("" : "+v"(fr), "+v"(fq));
        const int b = u.pn >> 2, col0 = ((u.pn & 3) * 2 + u.ty) * 128 + wc * 32 + 8 * fq;
#pragma unroll
        for (int ai = 0; ai < 2; ++ai)
#pragma unroll
            for (int m = 0; m < 4; ++m) { const int rr = (u.pm & 1) * BM + ai * HALF + wr * 64 + m * 16 + fr, k = 2 * rr + (u.pm >> 1);
                *(u32x4*)(MIX + (size_t)(b * SEQ + k) * DM + col0) = pack8(acc[ai][0][m][0], acc[ai][0][m][1]);
                if (k != 0) *(u32x4*)(MIX + (size_t)(b * SEQ + SEQ - k) * DM + col0) = pack8(acc[ai][1][m][0], acc[ai][1][m][1]); }
    }
};
struct EpiOut {
    static constexpr bool PERM = true;
    bf16_t* XGH; const float* igmix; const float* gmlp; float* ss;
    __device__ __forceinline__ void operator()(const Acc& acc, const Unit& u, int wr, int wc, int fr, int fq) const {
        const int row0 = u.pm * BM + wr * 64 + fr, col0 = u.pn * BM + wc * 32 + 8 * fq;
#pragma unroll
        for (int ai = 0; ai < 2; ++ai)
#pragma unroll
            for (int m = 0; m < 4; ++m) { const int r = row0 + ai * HALF + m * 16; const size_t o = (size_t)r * DM + col0; float s = 0.f;
#pragma unroll
                for (int bj = 0; bj < 2; ++bj) {
                    const u32x4 xw = *(const u32x4*)(XGH + o + bj * HALF);
                    const f32x4 i0 = *(const f32x4*)(igmix + col0 + bj * HALF), i1 = *(const f32x4*)(igmix + col0 + bj * HALF + 4), g0 = *(const f32x4*)(gmlp + col0 + bj * HALF), g1 = *(const f32x4*)(gmlp + col0 + bj * HALF + 4);
                    f32x4 x0, x1;
                    x0[0] = __builtin_bit_cast(float, xw.x << 16); x0[1] = __builtin_bit_cast(float, xw.x & 0xffff0000u); x0[2] = __builtin_bit_cast(float, xw.y << 16); x0[3] = __builtin_bit_cast(float, xw.y & 0xffff0000u);
                    x1[0] = __builtin_bit_cast(float, xw.z << 16); x1[1] = __builtin_bit_cast(float, xw.z & 0xffff0000u); x1[2] = __builtin_bit_cast(float, xw.w << 16); x1[3] = __builtin_bit_cast(float, xw.w & 0xffff0000u);
                    const f32x4 h0 = acc[ai][bj][m][0] + x0 * i0, h1 = acc[ai][bj][m][1] + x1 * i1;
                    s += (h0[0] * h0[0] + h0[1] * h0[1]) + (h0[2] * h0[2] + h0[3] * h0[3]) + (h1[0] * h1[0] + h1[1] * h1[1]) + (h1[2] * h1[2] + h1[3] * h1[3]);
                    *(u32x4*)(XGH + o + bj * HALF) = pack8(h0 * g0, h1 * g1);
                }
                s += __shfl_xor(s, 16); s += __shfl_xor(s, 32);
                if (fq == 0) unsafeAtomicAdd(ss + r, s);
            }
    }
};
struct EpiUp {
    static constexpr bool PERM = true;
    bf16_t* ACT;
    __device__ __forceinline__ void operator()(const Acc& acc, const Unit& u, int wr, int wc, int fr, int fq) const {
#pragma unroll
        for (int ai = 0; ai < 2; ++ai)
#pragma unroll
            for (int m = 0; m < 4; ++m) { const int R = ai * HALF + wr * 64 + m * 16 + fr;
                bf16_t* rowp = ACT + ((size_t)(u.pm * 128 + u.pn * 4 + (wc >> 1)) * 256 + R) * 64 + (wc & 1) * 32 + 8 * fq;
#pragma unroll
                for (int bj = 0; bj < 2; ++bj) { f32x4 v0 = acc[ai][bj][m][0], v1 = acc[ai][bj][m][1];
#pragma unroll
                    for (int j = 0; j < 4; ++j) { v0[j] = fmaxf(v0[j], 0.f); v0[j] *= v0[j]; v1[j] = fmaxf(v1[j], 0.f); v1[j] *= v1[j]; }
                    *(u32x4*)(rowp + bj * (2 * 256 * 64)) = pack8(v0, v1); } }
    }
};

struct EpiDown {
    static constexpr bool PERM = true;
    bf16_t* HGH; const float* igmlp; const float* ssin; float* ss;
    __device__ __forceinline__ void operator()(const Acc& acc, const Unit& u, int wr, int wc, int fr, int fq) const {
        const int row0 = u.pm * BM + wr * 64 + fr, col0 = u.pn * BM + wc * 32 + 8 * fq;
#pragma unroll
        for (int ai = 0; ai < 2; ++ai)
#pragma unroll
            for (int m = 0; m < 4; ++m) { const int r = row0 + ai * HALF + m * 16; const size_t o = (size_t)r * DM + col0; float s = 0.f;
                const float rs2 = __builtin_amdgcn_rcpf(ssin[r] * (1.0f / DM) + EPS);
#pragma unroll
                for (int bj = 0; bj < 2; ++bj) {
                    const u32x4 xw = *(const u32x4*)(HGH + o + bj * HALF);
                    const f32x4 i0 = *(const f32x4*)(igmlp + col0 + bj * HALF), i1 = *(const f32x4*)(igmlp + col0 + bj * HALF + 4);
                    f32x4 x0, x1;
                    x0[0] = __builtin_bit_cast(float, xw.x << 16); x0[1] = __builtin_bit_cast(float, xw.x & 0xffff0000u); x0[2] = __builtin_bit_cast(float, xw.y << 16); x0[3] = __builtin_bit_cast(float, xw.y & 0xffff0000u);
                    x1[0] = __builtin_bit_cast(float, xw.z << 16); x1[1] = __builtin_bit_cast(float, xw.z & 0xffff0000u); x1[2] = __builtin_bit_cast(float, xw.w << 16); x1[3] = __builtin_bit_cast(float, xw.w & 0xffff0000u);
                    const f32x4 h0 = acc[ai][bj][m][0] * rs2 + x0 * i0, h1 = acc[ai][bj][m][1] * rs2 + x1 * i1;
                    s += (h0[0] * h0[0] + h0[1] * h0[1]) + (h0[2] * h0[2] + h0[3] * h0[3]) + (h1[0] * h1[0] + h1[1] * h1[1]) + (h1[2] * h1[2] + h1[3] * h1[3]);
                    *(u32x4*)(HGH + o + bj * HALF) = pack8(h0, h1);
                }
                s += __shfl_xor(s, 16); s += __shfl_xor(s, 32);
                if (fq == 0) unsafeAtomicAdd(ss + r, s);
            }
    }
};

struct SchedFinal {
    int c; const char* A; const char* B;
    __device__ __forceinline__ bool next(int i, Unit& u) const { if (i >= 2) return false; const int x = c & 7, j = c >> 3; u.pm = i * 32 + x * 4 + (j >> 3); u.pn = j & 7; u.ty = 0; return true; }
    __device__ __forceinline__ void ptrs(const Unit& u, const char*& a, const char*& b) const { a = A + (size_t)u.pm * ((size_t)256 * DFF * 2); b = B + (size_t)u.pn * ((size_t)256 * DFF * 2); }
};
struct EpiFinal {
    static constexpr bool PERM = true;
    const bf16_t* HGH; const float* igmlp; const float* ssin; float* ss; unsigned* pcnt; const float* gfin; float* out;
    __device__ __forceinline__ void operator()(Acc& acc, const Unit& u, int wr, int wc, int fr_, int fq_) const {
        int fr = fr_, fq = fq_; asm volatile("" : "+v"(fr), "+v"(fq));
        const int row0 = u.pm * BM + wr * 64 + fr, col0 = u.pn * BM + wc * 32 + 8 * fq;
#pragma unroll
        for (int ai = 0; ai < 2; ++ai)
#pragma unroll
            for (int m = 0; m < 4; ++m) { const int r = row0 + ai * HALF + m * 16; const size_t o = (size_t)r * DM + col0; float s = 0.f;
                const float rs2 = __builtin_amdgcn_rcpf(ssin[r] * (1.0f / DM) + EPS);
#pragma unroll
                for (int bj = 0; bj < 2; ++bj) {
                    const u32x4 xw = *(const u32x4*)(HGH + o + bj * HALF);
                    const f32x4 i0 = *(const f32x4*)(igmlp + col0 + bj * HALF), i1 = *(const f32x4*)(igmlp + col0 + bj * HALF + 4);
                    f32x4 x0, x1;
                    x0[0] = __builtin_bit_cast(float, xw.x << 16); x0[1] = __builtin_bit_cast(float, xw.x & 0xffff0000u); x0[2] = __builtin_bit_cast(float, xw.y << 16); x0[3] = __builtin_bit_cast(float, xw.y & 0xffff0000u);
                    x1[0] = __builtin_bit_cast(float, xw.z << 16); x1[1] = __builtin_bit_cast(float, xw.z & 0xffff0000u); x1[2] = __builtin_bit_cast(float, xw.w << 16); x1[3] = __builtin_bit_cast(float, xw.w & 0xffff0000u);
                    const f32x4 h0 = acc[ai][bj][m][0] * rs2 + x0 * i0, h1 = acc[ai][bj][m][1] * rs2 + x1 * i1;
                    s += (h0[0] * h0[0] + h0[1] * h0[1]) + (h0[2] * h0[2] + h0[3] * h0[3]) + (h1[0] * h1[0] + h1[1] * h1[1]) + (h1[2] * h1[2] + h1[3] * h1[3]);
                    acc[ai][bj][m][0] = h0; acc[ai][bj][m][1] = h1;
                }
                s += __shfl_xor(s, 16); s += __shfl_xor(s, 32);
                if (fq == 0) unsafeAtomicAdd(ss + r, s);
            }
        asm volatile("s_waitcnt vmcnt(0)" ::: "memory");
        unsigned* pc = pcnt + 64 * u.pm;
        if (fr == 0 && fq == 0) __hip_atomic_fetch_add(pc, 1u, __ATOMIC_RELAXED, __HIP_MEMORY_SCOPE_AGENT);
        { unsigned sp = 0; while ((unsigned)__builtin_amdgcn_readfirstlane((int)__hip_atomic_load(pc, __ATOMIC_RELAXED, __HIP_MEMORY_SCOPE_AGENT)) < 64u) { __builtin_amdgcn_s_sleep(1); if (++sp > (1u << 20)) break; } }
#pragma unroll
        for (int ai = 0; ai < 2; ++ai)
#pragma unroll
            for (int m = 0; m < 4; ++m) { const int r = row0 + ai * HALF + m * 16; const size_t o = (size_t)r * DM + col0;
                const float rs = 1.0f / sqrtf(__hip_atomic_load(ss + r, __ATOMIC_RELAXED, __HIP_MEMORY_SCOPE_AGENT) * (1.0f / DM) + EPS);
#pragma unroll
                for (int bj = 0; bj < 2; ++bj) {
                    const f32x4 g0 = *(const f32x4*)(gfin + col0 + bj * HALF), g1 = *(const f32x4*)(gfin + col0 + bj * HALF + 4);
                    *(f32x4*)(out + o + bj * HALF) = acc[ai][bj][m][0] * rs * g0; *(f32x4*)(out + o + bj * HALF + 4) = acc[ai][bj][m][1] * rs * g1;
                }
            }
    }
};

template <class Epi, class Sched, bool ALIGN_EPI, bool SP2>
__device__ __forceinline__ void gemm_phase(LAS unsigned char* lds, const Gemm g, const Sched& S, const Epi& E, const int wid) {
    const int lane = lane_id();
    const int tid = wid * 64 + lane, wr = wid >> 2, wc = wid & 3, fr = lane & 15, fq = lane >> 4;
    const int K = g.K, nt = K / BK;
    unsigned voffA[2], voffB[2];
#pragma unroll
    for (int i = 0; i < 2; ++i) { int R, C; stage_rc(tid * 16 + i * 8192, R, C); const int Rb = Epi::PERM ? ((R & ~31) + perm32(R & 31)) : R;
        voffA[i] = (unsigned)(R * g.lda + C) * 2u; voffB[i] = (unsigned)(Rb * g.ldb + C) * 2u; }
    const size_t ksA = (size_t)g.ksA, ksB = (size_t)g.ksB;
    const size_t hstepA = (size_t)HALF * g.lda * 2, hstepB = (size_t)HALF * g.ldb * 2;
    const unsigned ldsw = (unsigned)wid * 1024u;
    const int aoff = lds_byte(wr * 64 + fr, fq * 8), boff = lds_byte(wc * 32 + fr, fq * 8);
#define PG8_SA(b, h) (((b) * 2 + (h)) * HTB)
#define PG8_SB(b, h) ((4 + (b) * 2 + (h)) * HTB)
#define PG8_STAGE(bufoff, gbase, voff) do { _Pragma("unroll") for (int _i = 0; _i < 2; ++_i) \
        __builtin_amdgcn_global_load_lds((const unsigned*)((const char*)(gbase) + (voff)[_i]), (LAS unsigned*)(lds + (bufoff) + ldsw + _i * 8192), 16, 0, 0); } while (0)
#define PG8_LDA(dst, b, h) do { _Pragma("unroll") for (int m = 0; m < 4; ++m) _Pragma("unroll") for (int k = 0; k < 2; ++k) dst[m][k] = *(const LAS bf16x8*)(lds + PG8_SA(b, h) + aoff + m * 2048 + k * 1024); } while (0)
#define PG8_LDB(dst, b, h) do { _Pragma("unroll") for (int n = 0; n < 2; ++n) _Pragma("unroll") for (int k = 0; k < 2; ++k) dst[n][k] = *(const LAS bf16x8*)(lds + PG8_SB(b, h) + boff + n * 2048 + k * 1024); } while (0)
#define PG8_MMA(ai, bj, At, Bt) do { __builtin_amdgcn_s_setprio(1); _Pragma("unroll") for (int m = 0; m < 4; ++m) _Pragma("unroll") for (int n = 0; n < 2; ++n) _Pragma("unroll") for (int k = 0; k < 2; ++k) \
        acc[ai][bj][m][n] = __builtin_amdgcn_mfma_f32_16x16x32_bf16(Bt[n][k], At[m][k], acc[ai][bj][m][n], 0, 0, 0); __builtin_amdgcn_s_setprio(0); } while (0)
#define PG8_WAIT_V(n) asm volatile("s_waitcnt vmcnt(" #n ")" ::: "memory")
#define PG8_WAIT_L(n) asm volatile("s_waitcnt lgkmcnt(" #n ")" ::: "memory")
#define PG8_BAR __builtin_amdgcn_s_barrier()
#define PG8_SCHED __builtin_amdgcn_sched_barrier(0)
    Unit cur, nxt; int ui = 0;
    if (!S.next(0, cur)) return;
    Acc acc;
#pragma unroll
    for (int a = 0; a < 2; ++a)
#pragma unroll
        for (int b = 0; b < 2; ++b)
#pragma unroll
            for (int m = 0; m < 4; ++m)
#pragma unroll
                for (int n = 0; n < 2; ++n) acc[a][b][m][n] = (f32x4){0.f, 0.f, 0.f, 0.f};
    bf16x8 At[4][2], B0[2][2], B1[2][2];
    const char* cA; const char* cB; S.ptrs(cur, cA, cB);
    if constexpr (SP2) {
        PG8_STAGE(PG8_SB(0, 0), cB, voffB); PG8_STAGE(PG8_SB(0, 1), cB + hstepB, voffB); PG8_STAGE(PG8_SA(0, 0), cA, voffA); PG8_STAGE(PG8_SA(0, 1), cA + hstepA, voffA);
        if (wr == 1) PG8_BAR;
        PG8_WAIT_V(2); PG8_BAR;
        PG8_STAGE(PG8_SB(1, 0), cB + ksB, voffB); PG8_STAGE(PG8_SA(1, 0), cA + ksA, voffA); PG8_STAGE(PG8_SB(1, 1), cB + hstepB + ksB, voffB);
        PG8_WAIT_V(6); PG8_BAR;
    } else {
        PG8_STAGE(PG8_SB(0, 0), cB, voffB); PG8_STAGE(PG8_SA(0, 0), cA, voffA); PG8_STAGE(PG8_SB(0, 1), cB + hstepB, voffB); PG8_STAGE(PG8_SA(0, 1), cA + hstepA, voffA);
        if (wr == 1) PG8_BAR;
        PG8_WAIT_V(4); PG8_BAR;
        PG8_STAGE(PG8_SB(1, 0), cB + ksB, voffB); PG8_STAGE(PG8_SA(1, 0), cA + ksA, voffA); PG8_STAGE(PG8_SB(1, 1), cB + hstepB + ksB, voffB);
        PG8_WAIT_V(6); PG8_BAR;
    }
    for (;;) {
        const bool has_next = S.next(ui + 1, nxt);
        const char* nA = cA; const char* nB = cB; if (has_next) S.ptrs(nxt, nA, nB);
        for (int t = 0; t < nt; t += 2) {
            const bool last = (t == nt - 2);
            const char* a1 = cA + (size_t)(t + 1) * ksA;
            const char* a2 = last ? nA : cA + (size_t)(t + 2) * ksA; const char* b2 = last ? nB : cB + (size_t)(t + 2) * ksB;
            const char* a3 = a2 + ksA; const char* b3 = b2 + ksB;
            if constexpr (SP2) {
            PG8_LDB(B0, 0, 0); PG8_LDB(B1, 0, 1); PG8_SCHED; PG8_LDA(At, 0, 0); PG8_STAGE(PG8_SA(1, 1), a1 + hstepA, voffA);
            PG8_WAIT_V(8); PG8_WAIT_L(0); PG8_BAR; PG8_MMA(0, 0, At, B0); PG8_MMA(0, 1, At, B1); PG8_BAR; PG8_SCHED;
            PG8_LDA(At, 0, 1); PG8_STAGE(PG8_SB(0, 0), b2, voffB); PG8_STAGE(PG8_SB(0, 1), b2 + hstepB, voffB); PG8_STAGE(PG8_SA(0, 0), a2, voffA);
            PG8_WAIT_V(8); PG8_WAIT_L(0); PG8_BAR; PG8_MMA(1, 0, At, B0); PG8_MMA(1, 1, At, B1); PG8_BAR; PG8_SCHED;
            PG8_LDB(B0, 1, 0); PG8_LDB(B1, 1, 1); PG8_SCHED; PG8_LDA(At, 1, 0); PG8_STAGE(PG8_SA(0, 1), a2 + hstepA, voffA);
            PG8_WAIT_V(8); PG8_WAIT_L(0); PG8_BAR; PG8_MMA(0, 0, At, B0); PG8_MMA(0, 1, At, B1); PG8_BAR; PG8_SCHED;
            PG8_LDA(At, 1, 1); PG8_STAGE(PG8_SB(1, 0), b3, voffB); PG8_STAGE(PG8_SB(1, 1), b3 + hstepB, voffB); PG8_STAGE(PG8_SA(1, 0), a3, voffA);
            PG8_WAIT_V(8); PG8_WAIT_L(0); PG8_BAR; PG8_MMA(1, 0, At, B0); PG8_MMA(1, 1, At, B1); PG8_BAR; PG8_SCHED;
            } else {
            PG8_LDB(B0, 0, 0); PG8_SCHED; PG8_LDA(At, 0, 0); PG8_STAGE(PG8_SA(1, 1), a1 + hstepA, voffA);
            PG8_WAIT_L(8); PG8_BAR; PG8_WAIT_L(0); PG8_MMA(0, 0, At, B0); PG8_BAR; PG8_SCHED;
            PG8_LDB(B1, 0, 1); PG8_STAGE(PG8_SB(0, 0), b2, voffB);
            PG8_BAR; PG8_WAIT_L(0); PG8_MMA(0, 1, At, B1); PG8_BAR;
            PG8_LDA(At, 0, 1); PG8_STAGE(PG8_SA(0, 0), a2, voffA);
            PG8_BAR; PG8_WAIT_L(0); PG8_MMA(1, 0, At, B0); PG8_BAR; PG8_SCHED;
            PG8_STAGE(PG8_SB(0, 1), b2 + hstepB, voffB);
            PG8_WAIT_V(6); PG8_BAR; PG8_MMA(1, 1, At, B1); PG8_BAR;
            PG8_LDB(B0, 1, 0); PG8_SCHED; PG8_LDA(At, 1, 0); PG8_STAGE(PG8_SA(0, 1), a2 + hstepA, voffA);
            PG8_WAIT_L(8); PG8_BAR; PG8_WAIT_L(0); PG8_MMA(0, 0, At, B0); PG8_BAR; PG8_SCHED;
            PG8_LDB(B1, 1, 1); PG8_STAGE(PG8_SB(1, 0), b3, voffB);
            PG8_BAR; PG8_WAIT_L(0); PG8_MMA(0, 1, At, B1); PG8_BAR;
            PG8_LDA(At, 1, 1); PG8_STAGE(PG8_SA(1, 0), a3, voffA);
            PG8_BAR; PG8_WAIT_L(0); PG8_MMA(1, 0, At, B0); PG8_BAR; PG8_SCHED;
            PG8_STAGE(PG8_SB(1, 1), b3 + hstepB, voffB);
            PG8_WAIT_V(6); PG8_BAR; PG8_MMA(1, 1, At, B1); PG8_BAR;
            }
        }
        if constexpr (ALIGN_EPI) { if (wr == 0) PG8_BAR; }
        E(acc, cur, wr, wc, fr, fq);
        if (!has_next) break;
#pragma unroll
        for (int a = 0; a < 2; ++a)
#pragma unroll
            for (int b = 0; b < 2; ++b)
#pragma unroll
                for (int m = 0; m < 4; ++m)
#pragma unroll
                    for (int n = 0; n < 2; ++n) acc[a][b][m][n] = (f32x4){0.f, 0.f, 0.f, 0.f};
        cur = nxt; cA = nA; cB = nB; ++ui;
        if constexpr (ALIGN_EPI) { if (wr == 1) PG8_BAR; }
    }
    PG8_WAIT_V(0);
    if constexpr (!ALIGN_EPI) { if (wr == 0) PG8_BAR; }
    PG8_BAR;
#undef PG8_SA
#undef PG8_SB
#undef PG8_STAGE
#undef PG8_LDA
#undef PG8_LDB
#undef PG8_MMA
#undef PG8_WAIT_V
#undef PG8_WAIT_L
#undef PG8_BAR
#undef PG8_SCHED
}

#define LDS_WAIT() asm volatile("s_waitcnt lgkmcnt(0)" ::: "memory")
__device__ __forceinline__ float wave_sum(float v) {
#pragma unroll
    for (int o = 1; o < 64; o <<= 1) v += __shfl_xor(v, o);
    return v;
}
__device__ __forceinline__ void tr_load(f32x4 (&v)[16], const float* W, int N, int item, int lane) {
    const int nblk = N >> 6, kb = item / nblk, nb = item - kb * nblk, k0 = kb << 6, n0 = nb << 6, lr = lane >> 4, lc = lane & 15;
    const float* src = W + (size_t)k0 * N + n0 + 4 * lc;
#pragma unroll
    for (int i = 0; i < 16; ++i) { const int kk = 8 * (i >> 1) + 2 * lr + (i & 1); v[i] = __builtin_nontemporal_load((const f32x4*)(src + (size_t)kk * N)); }
}
__device__ __forceinline__ void tr_store(const f32x4 (&v)[16], int K, int N, bf16_t* WT, LAS unsigned char* scr, int item, int lane_) {
    int lane = lane_; asm volatile("" : "+v"(lane));
    const int nblk = N >> 6, kb = item / nblk, nb = item - kb * nblk, k0 = kb << 6, n0 = nb << 6, lr = lane >> 4, lc = lane & 15;
#pragma unroll
    for (int ip = 0; ip < 8; ++ip)
#pragma unroll
        for (int e = 0; e < 4; ++e) *(LAS unsigned*)(scr + (4 * lc + e) * 128 + ((ip ^ (lc & 7)) << 4) + 4 * lr) = cvt_pk_bf16(v[2 * ip][e], v[2 * ip + 1][e]);
    LDS_WAIT(); asm volatile("" ::: "memory");
    const int c = lane & 7;
#pragma unroll
    for (int j = 0; j < 8; ++j) { const int n = (lane >> 3) + 8 * j;
        const u32x4 o = *(const LAS u32x4*)(scr + n * 128 + ((c ^ ((n >> 2) & 7)) << 4));
        *(u32x4*)(WT + (size_t)(n0 + n) * K + k0 + 8 * c) = o; }
    LDS_WAIT(); asm volatile("" ::: "memory");
}
__device__ __forceinline__ void p0_transpose_item(const float* W, int K, int N, bf16_t* WT, LAS unsigned char* scr, int item, int lane) {
    f32x4 v[16]; tr_load(v, W, N, item, lane); tr_store(v, K, N, WT, scr, item, lane);
}

struct Args { const float* in[12]; float* out; unsigned char* ws; };

__global__ void __launch_bounds__(512, 2) fwd_megakernel(Args args) {
    extern __shared__ __attribute__((aligned(16))) unsigned char lds_raw[];
    LAS unsigned char* lds = (LAS unsigned char*)lds_raw;
    cg::grid_group grid = cg::this_grid();
    const int tid = threadIdx.x, lane = tid & 63, wave = __builtin_amdgcn_readfirstlane(tid >> 6);
    const int G = gridDim.x, bx = blockIdx.x;
    unsigned char* ws = args.ws;
    const float* x = args.in[0]; const float* g_mix = args.in[1]; const float* w_in = args.in[2]; const float* w_f = args.in[3];
    const float* g_v = args.in[4]; const float* w_s = args.in[5]; const float* b_s = args.in[6]; const float* w_out = args.in[7];
    const float* g_mlp = args.in[8]; const float* w_up = args.in[9]; const float* w_dn = args.in[10]; const float* g_fin = args.in[11];
    float* out = args.out;
    unsigned* gbar = (unsigned*)(ws + WS_BAR); unsigned* pcnt = (unsigned*)(ws + WS_PCNT); float* ya = (float*)(ws + WS_YA); float* igmix = (float*)(ws + WS_IGMIX); float* igmlp = (float*)(ws + WS_IGMLP);
    float* rstd_x = (float*)(ws + WS_RSX); float* ss_h = (float*)(ws + WS_SSH); float* ss_h2 = (float*)(ws + WS_SSH2);
    bf16_t* GT = (bf16_t*)(ws + WS_GT); bf16_t* WIN = (bf16_t*)(ws + WS_WIN); bf16_t* WOUT = (bf16_t*)(ws + WS_WOUT);
    bf16_t* WUP = (bf16_t*)(ws + WS_WUP); bf16_t* WDN = (bf16_t*)(ws + WS_WDN); bf16_t* DFT = (bf16_t*)(ws + WS_DFT);
    bf16_t* XG = (bf16_t*)(ws + WS_XG); bf16_t* PF = (bf16_t*)(ws + WS_PF); bf16_t* U = (bf16_t*)(ws + WS_U); bf16_t* VT = (bf16_t*)(ws + WS_VT);
    bf16_t* B12 = (bf16_t*)(ws + WS_B12); bf16_t* MIX = (bf16_t*)(ws + WS_MIX); bf16_t* ACT = (bf16_t*)(ws + WS_ACT);

    volatile LAS unsigned* xst = (volatile LAS unsigned*)(lds + 131072 + 1024);
    if (tid == 0) { xst[0] = 0u; xst[1] = 0u; }
    const unsigned xcc = xb_xcc_id();
    for (int i = bx * 512 + tid; i < XCD_BAR_WORDS; i += G * 512) gbar[i] = 0u;
    grid.sync();
    if (tid == 0) (void)xb_add(&gbar[XB_XCNT(xcc)], 1u);
    {
        const int gw = bx * 8 + wave, NGW = G * 8, gt = bx * 512 + tid, NGT = G * 512;
        for (int i = gt; i < MT; i += NGT) { ss_h[i] = 0.f; ss_h2[i] = 0.f; if (i < NB * FW) ya[i] = 0.f; if (i < DM) { igmix[i] = 1.0f / g_mix[i]; igmlp[i] = 1.0f / g_mlp[i]; } if (i < 64 * 64) pcnt[i] = 0u; }
        for (int vb = bx; vb < 256; vb += G) {
            const int g = vb >> 5, sub = vb & 31;
            LAS float* wl = (LAS float*)lds;
#pragma unroll
            for (int i = 0; i < 8; ++i) ((LAS f32x4*)wl)[tid + 512 * i] = ((const f32x4*)(w_f + (size_t)g * 16384))[tid + 512 * i];
            __syncthreads();
            const int d = tid & 127, p = sub * 8 + (tid >> 7) * 2, cs = p >> 7, c = p & 127;
            float a0 = 0.f, a1 = 0.f;
#pragma unroll 8
            for (int j = 0; j < 128; ++j) { const float w = wl[j * 128 + d];
                const float p0 = (float)((c * j) & 127) * (1.0f / 128.0f), p1 = (float)(((c + 1) * j) & 127) * (1.0f / 128.0f);
                const float t0 = cs ? -__builtin_amdgcn_sinf(p0) : __builtin_amdgcn_cosf(p0), t1 = cs ? -__builtin_amdgcn_sinf(p1) : __builtin_amdgcn_cosf(p1);
                a0 += t0 * w; a1 += t1 * w; }
            { const float v0 = a0 * (1.0f / 512.0f), v1 = a1 * (1.0f / 512.0f);
              *(unsigned*)(GT + (size_t)g * 65536 + (size_t)d * 256 + cs * 128 + c) = cvt_pk_bf16(v0, v1);
              *(unsigned*)(GT + (size_t)g * 65536 + (size_t)(128 + d) * 256 + cs * 128 + c) = cs ? cvt_pk_bf16(-v0, -v1) : cvt_pk_bf16(v0, v1); }
            __syncthreads();
        }
        LAS unsigned char* scr = lds + wave * 16384;
        constexpr int I_IN = (DM / 64) * (NIN / 64), I_OUT = (DM / 64) * (DM / 64);
        for (int it = gw; it < I_IN + I_OUT; it += NGW) { if (it < I_IN) p0_transpose_item(w_in, DM, NIN, WIN, scr, it, lane); else p0_transpose_item(w_out, DM, DM, WOUT, scr, it - I_IN, lane); }
        for (int m = 2 * gw; m < MT; m += 2 * NGW) {
            const f32x4* xr = (const f32x4*)(x + (size_t)m * DM) + lane; const f32x4* gr = (const f32x4*)g_mix + lane;
            f32x4 v[2][8]; float s0 = 0.f, s1 = 0.f;
#pragma unroll
            for (int j = 0; j < 8; ++j) { v[0][j] = __builtin_nontemporal_load(xr + 64 * j); v[1][j] = __builtin_nontemporal_load(xr + 512 + 64 * j); }
#pragma unroll
            for (int j = 0; j < 8; ++j) { s0 += (v[0][j][0] * v[0][j][0] + v[0][j][1] * v[0][j][1]) + (v[0][j][2] * v[0][j][2] + v[0][j][3] * v[0][j][3]);
                                          s1 += (v[1][j][0] * v[1][j][0] + v[1][j][1] * v[1][j][1]) + (v[1][j][2] * v[1][j][2] + v[1][j][3] * v[1][j][3]); }
            s0 = wave_sum(s0); s1 = wave_sum(s1);
            if (lane == 0) { rstd_x[m] = 1.0f / sqrtf(s0 * (1.0f / DM) + EPS); rstd_x[m + 1] = 1.0f / sqrtf(s1 * (1.0f / DM) + EPS); }
            unsigned long long* o8 = (unsigned long long*)(XG + (size_t)m * DM) + lane;
#pragma unroll
            for (int j = 0; j < 8; ++j) { const f32x4 gg = gr[64 * j]; const f32x4 t0 = v[0][j] * gg, t1 = v[1][j] * gg;
                o8[64 * j] = (unsigned long long)cvt_pk_bf16(t0[0], t0[1]) | ((unsigned long long)cvt_pk_bf16(t0[2], t0[3]) << 32);
                o8[512 + 64 * j] = (unsigned long long)cvt_pk_bf16(t1[0], t1[1]) | ((unsigned long long)cvt_pk_bf16(t1[2], t1[3]) << 32); }
        }
        for (int q = gt; q < 1024 * 256; q += NGT) {
            const int r = q >> 8, col0 = (q & 255) * 8, cs = col0 >> 10, s0 = col0 & 1023, k = r < 512 ? 2 * r : 2 * (r - 512) + 1;
            float v[8];
#pragma unroll
            for (int j = 0; j < 8; ++j) { const float ph = (float)((k * (s0 + j)) & 2047) * (1.0f / 2048.0f); v[j] = cs ? __builtin_amdgcn_sinf(ph) : __builtin_amdgcn_cosf(ph); }
            u32x4 o; o.x = cvt_pk_bf16(v[0], v[1]); o.y = cvt_pk_bf16(v[2], v[3]); o.z = cvt_pk_bf16(v[4], v[5]); o.w = cvt_pk_bf16(v[6], v[7]);
            *(u32x4*)(DFT + (size_t)r * 2048 + col0) = o;
        }
    }
    xcd_barrier(gbar, xcc, xst, (unsigned)G, wave * 64 + lane_id());

    {
        Gemm g{DM, DM, DM}; SchedIn S{bx, (const char*)XG, (const char*)WIN};
        EpiIn E{B12, U, VT, rstd_x, ya};
        gemm_phase<EpiIn, SchedIn, true, true>(lds, g, S, E, wave);
    }
    xcd_barrier(gbar, xcc, xst, (unsigned)G, wave * 64 + lane_id());

    {
        const int NW = G >> 1;
        if (bx < NW) {
            { Gemm g{2048, 2048, SEQ / 2}; SchedPair S{bx, NW, (const char*)DFT, (const char*)B12};
              EpiDftZ E{PF};
              gemm_phase<EpiDftZ, SchedPair, true, true>(lds, g, S, E, wave); }
            { Gemm g{256, 256, 256}; SchedPost S{bx, NW, (const char*)PF, (const char*)GT};
              EpiPost E{MIX};
              gemm_phase<EpiPost, SchedPost, true, true>(lds, g, S, E, wave); }
            {
                const int ww = bx * 8 + wave, NWW = NW * 8, ln = lane_id(); LAS unsigned char* scr = lds + wave * 16384;
                constexpr int I_DN = (DFF / 64) * (DM / 64);
                for (int it = ww; it < I_DN; it += 2 * NWW) { const int it2 = it + NWW; const bool two = it2 < I_DN;
                    f32x4 va[16], vb[16];
                    tr_load(va, w_dn, DM, it, ln); if (two) tr_load(vb, w_dn, DM, it2, ln);
                    tr_store(va, DFF, DM, WDN, scr, it, ln); if (two) tr_store(vb, DFF, DM, WDN, scr, it2, ln); }
            }
        } else {
            const int hw = (bx - NW) * 8 + wave, NHW = (G - NW) * 8, ln = lane_id();
            for (int n = hw; n < NB * FW; n += NHW) {
                const int d = n & 127, g = (n >> 7) & 7; const unsigned gw2 = *(const unsigned*)(GT + (size_t)g * 65536 + (size_t)d * 256 + 2 * ln);
                const float y0 = ya[(n & ~127) + 2 * ln], y1 = ya[(n & ~127) + 2 * ln + 1];
                float t = __builtin_bit_cast(float, gw2 << 16) * y0 + __builtin_bit_cast(float, gw2 & 0xffff0000u) * y1;
                t = wave_sum(t);
                if (ln == 0) MIX[(size_t)((n >> 10) * SEQ + SEQ / 2) * DM + (n & 1023)] = (bf16_t)(cvt_pk_bf16(t, 0.f) & 0xffffu);
            }
    {
        const int w4 = wave & 3, sub = wave >> 2;
        bf16x8 bfr[2][4][2];
        if (bx - NW < 512) { const int u0 = (bx - NW) * 2 + sub; const unsigned l16 = (unsigned)lane_id() * 16u;
            const bf16_t* v0 = VT + (size_t)((((u0 >> 7) * 16 + ((u0 >> 3) & 15)) * 8 + (u0 & 7)) * 128) * 128;
#pragma unroll
            for (int ks = 0; ks < 2; ++ks)
#pragma unroll
                for (int gp = 0; gp < 4; ++gp)
#pragma unroll
                    for (int nn = 0; nn < 2; ++nn) bfr[ks][gp][nn] = *(const bf16x8*)((const char*)v0 + ((ks * 4 + gp) * 2 + nn) * 1024 + l16); }
        for (int it = bx - NW; it < 512; it += G - NW) {
            const int ln = lane_id(), fr = ln & 15, fq = ln >> 4; const unsigned lo16 = (unsigned)ln * 16u;
            const int unit = it * 2 + sub, h = unit & 7, n = (unit >> 3) & 15, b = unit >> 7, tok0 = b * SEQ + n * 128;
            const bf16_t* vt = VT + (size_t)(((b * 16 + n) * 8 + h) * 128) * 128;
            const float* wsh = w_s + (size_t)h * 128 * 128;
            f32x4 acc[2][4][2];
#pragma unroll
            for (int mi = 0; mi < 2; ++mi)
#pragma unroll
                for (int gp = 0; gp < 4; ++gp)
#pragma unroll
                    for (int nn = 0; nn < 2; ++nn) acc[mi][gp][nn] = (f32x4){0.f, 0.f, 0.f, 0.f};
            bf16x8 u8[2][4];
#pragma unroll
            for (int ks = 0; ks < 4; ++ks) {
                f32x4 wv[2][2];
#pragma unroll
                for (int mi = 0; mi < 2; ++mi) { const float* wp = wsh + (32 * w4 + 16 * mi + fr) * 128 + ks * 32 + fq * 8; wv[mi][0] = *(const f32x4*)wp; wv[mi][1] = *(const f32x4*)(wp + 4); }
                float ss[8];
#pragma unroll
                for (int j = 0; j < 8; ++j) ss[j] = 0.f;
#pragma unroll
                for (int gp = 0; gp < 4; ++gp)
#pragma unroll
                    for (int nn = 0; nn < 2; ++nn)
#pragma unroll
                        for (int j = 0; j < 8; ++j) { const float v = bf2f((unsigned short)bfr[ks & 1][gp][nn][j]); ss[j] += v * v; }
#pragma unroll
                for (int j = 0; j < 8; ++j) { float sv = ss[j];
                    sv += __builtin_bit_cast(float, __builtin_amdgcn_update_dpp(0, __builtin_bit_cast(int, sv), 0x128, 0xf, 0xf, false));
                    sv += __builtin_bit_cast(float, __builtin_amdgcn_update_dpp(0, __builtin_bit_cast(int, sv), 0x124, 0xf, 0xf, false));
                    sv += __builtin_bit_cast(float, __builtin_amdgcn_update_dpp(0, __builtin_bit_cast(int, sv), 0x122, 0xf, 0xf, false));
                    sv += __builtin_bit_cast(float, __builtin_amdgcn_update_dpp(0, __builtin_bit_cast(int, sv), 0x121, 0xf, 0xf, false));
                    ss[j] = __builtin_amdgcn_rsqf(sv * (1.0f / 128.0f) + EPS); }
                bf16x8 afr[2];
#pragma unroll
                for (int mi = 0; mi < 2; ++mi) { const f32x4 w0 = wv[mi][0], w1 = wv[mi][1];
                    u32x4 pk; pk.x = cvt_pk_bf16(w0[0] * ss[0], w0[1] * ss[1]); pk.y = cvt_pk_bf16(w0[2] * ss[2], w0[3] * ss[3]); pk.z = cvt_pk_bf16(w1[0] * ss[4], w1[1] * ss[5]); pk.w = cvt_pk_bf16(w1[2] * ss[6], w1[3] * ss[7]);
                    afr[mi] = __builtin_bit_cast(bf16x8, pk); }
#pragma unroll
                for (int mi = 0; mi < 2; ++mi)
#pragma unroll
                    for (int gp = 0; gp < 4; ++gp)
#pragma unroll
                        for (int nn = 0; nn < 2; ++nn) acc[mi][gp][nn] = __builtin_amdgcn_mfma_f32_16x16x32_bf16(bfr[ks & 1][gp][nn], afr[mi], acc[mi][gp][nn], 0, 0, 0);
                if (ks < 2) {
                    asm volatile("" ::: "memory");
#pragma unroll
                    for (int gp = 0; gp < 4; ++gp)
#pragma unroll
                        for (int nn = 0; nn < 2; ++nn) bfr[ks][gp][nn] = *(const bf16x8*)((const char*)vt + (((ks + 2) * 4 + gp) * 2 + nn) * 1024 + lo16);
                }
            }
            asm volatile("" ::: "memory");
#pragma unroll
            for (int mi = 0; mi < 2; ++mi)
#pragma unroll
                for (int gp = 0; gp < 4; ++gp) u8[mi][gp] = *(const bf16x8*)(U + (size_t)(tok0 + 32 * w4 + 16 * mi + fr) * FW + h * 128 + 32 * gp + 8 * fq);
            { const int itn = it + (G - NW);
              if (itn < 512) { const int un = itn * 2 + sub; const bf16_t* vn = VT + (size_t)((((un >> 7) * 16 + ((un >> 3) & 15)) * 8 + (un & 7)) * 128) * 128;
#pragma unroll
                for (int ks = 0; ks < 2; ++ks)
#pragma unroll
                    for (int gp = 0; gp < 4; ++gp)
#pragma unroll
                        for (int nn = 0; nn < 2; ++nn) bfr[ks][gp][nn] = *(const bf16x8*)((const char*)vn + ((ks * 4 + gp) * 2 + nn) * 1024 + lo16); } }
#pragma unroll
            for (int mi = 0; mi < 2; ++mi) { const int p = 32 * w4 + 16 * mi + fr, tok = tok0 + p; const float bias = b_s[h * 128 + p];
#pragma unroll
                for (int gp = 0; gp < 4; ++gp) { const int d0 = 32 * gp + 8 * fq;
                    const f32x4 gv0 = *(const f32x4*)(g_v + h * 128 + d0), gv1 = *(const f32x4*)(g_v + h * 128 + d0 + 4);
                    f32x4 y0, y1;
#pragma unroll
                    for (int j = 0; j < 4; ++j) { y0[j] = bf2f((unsigned short)u8[mi][gp][j]) * (acc[mi][gp][0][j] * gv0[j] + bias); y1[j] = bf2f((unsigned short)u8[mi][gp][4 + j]) * (acc[mi][gp][1][j] * gv1[j] + bias); }
                    *(u32x4*)(MIX + (size_t)tok * DM + FW + h * 128 + d0) = pack8(y0, y1); } }
        }
    }
            LAS unsigned char* scr = lds + wave * 16384;
            constexpr int I_UP = (DM / 64) * (DFF / 64);
            for (int it = hw; it < I_UP; it += 2 * NHW) {
                const int it2 = it + NHW; const bool two = it2 < I_UP;
                f32x4 va[16], vb[16];
                tr_load(va, w_up, DFF, it, ln); if (two) tr_load(vb, w_up, DFF, it2, ln);
                tr_store(va, DM, DFF, WUP, scr, it, ln); if (two) tr_store(vb, DM, DFF, WUP, scr, it2, ln);
            }
        }
    }
    xcd_barrier(gbar, xcc, xst, (unsigned)G, wave * 64 + lane_id());

    {
        Gemm g{DM, DM, DM}; SchedStd S; S.so.init(MT, DM, G, bx); S.A = (const char*)MIX; S.B = (const char*)WOUT; S.ta = (size_t)256 * DM * 2; S.tb = (size_t)256 * DM * 2;
        EpiOut E{XG, igmix, g_mlp, ss_h};
        gemm_phase<EpiOut, SchedStd, true, true>(lds, g, S, E, wave);
    }
    xcd_barrier(gbar, xcc, xst, (unsigned)G, wave * 64 + lane_id());

    {
        Gemm g{DM, DM, DM}; SchedStd S; S.so.init(MT, DFF, G, bx); S.A = (const char*)XG; S.B = (const char*)WUP; S.ta = (size_t)256 * DM * 2; S.tb = (size_t)256 * DM * 2;
        EpiUp E{ACT};
        gemm_phase<EpiUp, SchedStd, true, true>(lds, g, S, E, wave);
    }
    xcd_barrier(gbar, xcc, xst, (unsigned)G, wave * 64 + lane_id());

    if (G == 256) {
        Gemm g{64, DFF, DFF, 256 * 64 * 2, BK * 2}; SchedFinal S{bx, (const char*)ACT, (const char*)WDN};
        EpiFinal E{XG, igmlp, ss_h, ss_h2, pcnt, g_fin, out};
        gemm_phase<EpiFinal, SchedFinal, true, true>(lds, g, S, E, wave);
    } else {
    {
        Gemm g{64, DFF, DFF, 256 * 64 * 2, BK * 2}; SchedStd S; S.so.init(MT, DM, G, bx); S.A = (const char*)ACT; S.B = (const char*)WDN; S.ta = (size_t)256 * DFF * 2; S.tb = (size_t)256 * DFF * 2;
        EpiDown E{XG, igmlp, ss_h, ss_h2};
        gemm_phase<EpiDown, SchedStd, true, true>(lds, g, S, E, wave);
    }
    xcd_barrier(gbar, xcc, xst, (unsigned)G, wave * 64 + lane_id());

    {
        const int gw = bx * 8 + wave, NGW = G * 8, ln = lane_id();
        for (int m = 2 * gw; m < MT; m += 2 * NGW) {
            const u32x4* hrow = (const u32x4*)(XG + (size_t)m * DM) + ln; f32x4* orow = (f32x4*)(out + (size_t)m * DM) + 2 * ln; const f32x4* gr = (const f32x4*)g_fin + 2 * ln;
            u32x4 hv[2][4];
#pragma unroll
            for (int j = 0; j < 4; ++j) { hv[0][j] = hrow[64 * j]; hv[1][j] = hrow[256 + 64 * j]; }
            const float rs0 = 1.0f / sqrtf(ss_h2[m] * (1.0f / DM) + EPS), rs1 = 1.0f / sqrtf(ss_h2[m + 1] * (1.0f / DM) + EPS);
#pragma unroll
            for (int j = 0; j < 4; ++j) { const f32x4 g0 = gr[128 * j], g1 = gr[128 * j + 1];
#pragma unroll
                for (int rr = 0; rr < 2; ++rr) { const u32x4 h = hv[rr][j]; const float rs = rr ? rs1 : rs0; f32x4 v0, v1;
                    v0[0] = __builtin_bit_cast(float, h.x << 16); v0[1] = __builtin_bit_cast(float, h.x & 0xffff0000u); v0[2] = __builtin_bit_cast(float, h.y << 16); v0[3] = __builtin_bit_cast(float, h.y & 0xffff0000u);
                    v1[0] = __builtin_bit_cast(float, h.z << 16); v1[1] = __builtin_bit_cast(float, h.z & 0xffff0000u); v1[2] = __builtin_bit_cast(float, h.w << 16); v1[3] = __builtin_bit_cast(float, h.w & 0xffff0000u);
                    orow[rr * 512 + 128 * j] = v0 * rs * g0; orow[rr * 512 + 128 * j + 1] = v1 * rs * g1; } }
        }
    }
    }
}

extern "C" void kernel_launch(void* const* d_in, const int* in_sizes, int n_in, void* d_out, int out_size, void* d_ws, size_t ws_size, hipStream_t stream) {
    static int grid_blocks = 0;
    if (grid_blocks == 0) {
        if (n_in != 12 || in_sizes[0] != MT * DM || out_size != MT * DM || ws_size < WS_END) { fprintf(stderr, "kernel_launch: unexpected shapes (n_in %d, in0 %d, out %d, ws %zu)\n", n_in, n_in > 0 ? in_sizes[0] : -1, out_size, ws_size); grid_blocks = -1; return; }
        int dev = 0, cus = 0, per_cu = 0;
        hipGetDevice(&dev);
        hipDeviceGetAttribute(&cus, hipDeviceAttributeMultiprocessorCount, dev);
        if (hipFuncSetAttribute((const void*)fwd_megakernel, hipFuncAttributeMaxDynamicSharedMemorySize, LDS_BYTES) != hipSuccess) { fprintf(stderr, "kernel_launch: hipFuncSetAttribute failed\n"); grid_blocks = -1; return; }
        hipOccupancyMaxActiveBlocksPerMultiprocessor(&per_cu, (const void*)fwd_megakernel, 512, LDS_BYTES);
        if (per_cu < 1) { fprintf(stderr, "kernel_launch: occupancy query says %d blocks/CU\n", per_cu); per_cu = 1; }
        (void)hipGetLastError();
        grid_blocks = cus * per_cu;
        if (grid_blocks != 256) fprintf(stderr, "kernel_launch: the in-proj unit order assumes a 256-workgroup grid (got %d): output will be wrong\n", grid_blocks);
    }
    if (grid_blocks < 0) return;
    Args a{};
    for (int i = 0; i < 12; ++i) a.in[i] = (const float*)d_in[i];
    a.out = (float*)d_out; a.ws = (unsigned char*)d_ws;
    void* kargs[] = {&a};
    hipError_t e = hipLaunchCooperativeKernel((const void*)fwd_megakernel, dim3(grid_blocks), dim3(512), kargs, LDS_BYTES, stream);
    if (e != hipSuccess) fprintf(stderr, "cooperative launch failed: %s (grid %d)\n", hipGetErrorString(e), grid_blocks);
}
```

```cpp
#include <hip/hip_runtime.h>
#include <hip/hip_cooperative_groups.h>
#include <cstdio>
#include <cstdint>
namespace cg = cooperative_groups;

#define LAS __attribute__((address_space(3)))
#define GAS __attribute__((address_space(1)))
typedef unsigned short bf16_t;
typedef short bf16x8 __attribute__((ext_vector_type(8)));
typedef float f32x4 __attribute__((ext_vector_type(4)));
typedef float f32x2 __attribute__((ext_vector_type(2)));
typedef unsigned u32x4 __attribute__((ext_vector_type(4)));

constexpr int DM = 2048, SEQ = 2048, NB = 8, MT = NB * SEQ;
constexpr int FW = 1024, NIN = 3072, DFF = 8192;
constexpr float EPS = 1e-6f;

constexpr size_t MiB = 1u << 20;
constexpr size_t WS_RSX = 0, WS_SSH = 64 * 1024, WS_SSH2 = 128 * 1024;
constexpr size_t WS_BAR = 256 * 1024;
constexpr size_t WS_PCNT = 320 * 1024;
constexpr size_t WS_IGMIX = 384 * 1024, WS_IGMLP = 400 * 1024;
constexpr size_t WS_YA = 576 * 1024;
constexpr size_t WS_Y1024 = 512 * 1024;
constexpr size_t WS_GT = 1 * MiB;
constexpr size_t WS_WIN = 2 * MiB;
constexpr size_t WS_WOUT = 14 * MiB;
constexpr size_t WS_WUP = 22 * MiB;
constexpr size_t WS_WDN = 54 * MiB;
constexpr size_t WS_DFT = 86 * MiB;
constexpr size_t WS_XG = 102 * MiB;
constexpr size_t WS_PF = 166 * MiB;
constexpr size_t WS_U = 198 * MiB;
constexpr size_t WS_VT = 230 * MiB;
constexpr size_t WS_B12 = 262 * MiB;
constexpr size_t WS_MIX = 326 * MiB;
constexpr size_t WS_ACT = 166 * MiB;
constexpr size_t WS_END = 422 * MiB;

constexpr int BM = 256, BK = 64, HALF = 128, HTB = HALF * BK * 2, STAGE_BYTES = 8 * HTB, NXCD = 8, WGM = 8;
constexpr int LDS_BYTES = 147456;

__host__ __device__ __forceinline__ int lds_byte(int r, int c) { const int st = (r >> 4) * 2 + (c >> 5), rr = r & 15, cc = c & 31, ob = rr * 64 + cc * 2; return st * 1024 + (ob ^ (((ob >> 9) & 1) << 5)); }
__host__ __device__ __forceinline__ void stage_rc(int b, int& R, int& C) { const int st = b / 1024, sb = b % 1024, swz = sb ^ (((sb >> 9) & 1) << 5); R = (st >> 1) * 16 + swz / 64; C = (st & 1) * 32 + (swz % 64) / 2; }
__host__ __device__ __forceinline__ int perm32(int rho) { const int n = rho >> 4, i = rho & 15; return 8 * (i >> 2) + 4 * n + (i & 3); }

struct Unit { int pm, pn, ty; };
struct Gemm { int lda, ldb, K; int ksA = BK * 2, ksB = BK * 2; };

struct StaticOrder {
    int nM, nN, nwg, G, c;
    __device__ void init(int M, int N, int G_, int c_) { nM = M / BM; nN = N / BM; nwg = nM * nN; G = G_; c = c_; }
    __device__ bool next(int i, Unit& u) const {
        const long L = (long)i * G + c; if (L >= nwg) return false;
        int wgid = (int)L; { const int q = nwg / NXCD, r = nwg % NXCD, xcd = wgid % NXCD, off = wgid / NXCD; wgid = (xcd < r ? xcd * (q + 1) : r * (q + 1) + (xcd - r) * q) + off; }
        const int nig = WGM * nN, gid = wgid / nig, fm = gid * WGM, gsz = (nM - fm) < WGM ? (nM - fm) : WGM;
        u.pm = fm + ((wgid % nig) % gsz); u.pn = (wgid % nig) / gsz; u.ty = 0; return true;
    }
};

__device__ __forceinline__ unsigned cvt_pk_bf16(float lo, float hi) { unsigned r; asm volatile("v_cvt_pk_bf16_f32 %0, %1, %2" : "=v"(r) : "v"(lo), "v"(hi)); return r; }
__device__ __forceinline__ float bf2f(unsigned short b) { return __builtin_bit_cast(float, ((unsigned)b) << 16); }
__device__ __forceinline__ f32x2 gelu_pk(f32x2 v) {
    const f32x2 av = __builtin_elementwise_abs(v), d = av * 0.2316418882f + 1.0f;
    f32x2 t; t.x = __builtin_amdgcn_rcpf(d.x); t.y = __builtin_amdgcn_rcpf(d.y);
    f32x2 q = t * 0.5307027145f + (-0.7265760135f); q = q * t + 0.7107068705f; q = q * t + (-0.142248368f); q = q * t + 0.127414796f; q = q * t;
    const f32x2 s = (v * v) * (-0.72134752044f);
    f32x2 e; e.x = __builtin_amdgcn_exp2f(s.x); e.y = __builtin_amdgcn_exp2f(s.y);
    const f32x2 m = v * (q * e), r = v - m;
    f32x2 o; o.x = v.x < 0.f ? m.x : r.x; o.y = v.y < 0.f ? m.y : r.y; return o;
}
__device__ __forceinline__ f32x4 gelu4(f32x4 v) { f32x2 a = gelu_pk((f32x2){v[0], v[1]}), b = gelu_pk((f32x2){v[2], v[3]}); return (f32x4){a.x, a.y, b.x, b.y}; }
__device__ __forceinline__ u32x4 pack8(f32x4 v0, f32x4 v1) { u32x4 w; w.x = cvt_pk_bf16(v0[0], v0[1]); w.y = cvt_pk_bf16(v0[2], v0[3]); w.z = cvt_pk_bf16(v1[0], v1[1]); w.w = cvt_pk_bf16(v1[2], v1[3]); return w; }

__device__ __forceinline__ int lane_id() { int l; asm volatile("v_mbcnt_lo_u32_b32 %0, -1, 0\n\tv_mbcnt_hi_u32_b32 %0, -1, %0" : "=v"(l)); return l; }
#define XB_TMO      128
#define XB_XCNT(j)  (256  + 64 * (j))
#define XB_XSUB(j)  (1280 + 64 * (j))
#define XB_XGEN(j)  (2304 + 64 * (j))
#define XB_TOP      3328
#define XB_TOPGEN   3392
#define XCD_BAR_WORDS 3456
#define XB_SPIN_CAP (1u << 20)
__device__ __forceinline__ unsigned xb_ld(unsigned* p)              { return __hip_atomic_load(p, __ATOMIC_RELAXED, __HIP_MEMORY_SCOPE_AGENT); }
__device__ __forceinline__ unsigned xb_add(unsigned* p, unsigned v) { return __hip_atomic_fetch_add(p, v, __ATOMIC_RELAXED, __HIP_MEMORY_SCOPE_AGENT); }
__device__ __forceinline__ unsigned xb_xcc_id() { return (unsigned)__builtin_amdgcn_s_getreg((3 << 11) | 20) & 0xFu; }
#define XB_SPIN(cond, bar) do { unsigned _sp = 0; while (cond) { __builtin_amdgcn_s_sleep(1); \
    if ((++_sp & 255u) == 0u) { if (xb_ld(&(bar)[XB_TMO])) break; if (_sp > XB_SPIN_CAP) { atomicAdd(&(bar)[XB_TMO], 1u); break; } } } } while (0)
__device__ __forceinline__ void xcd_barrier_complete(unsigned* bar, unsigned x, unsigned G, unsigned& nloc, unsigned& nx) {
    unsigned sum, cnt, mine, sp = 0u;
    for (;;) {
        sum = 0u; cnt = 0u; mine = 0u;
#pragma unroll
        for (unsigned j = 0; j < 16; ++j) { const unsigned c = xb_ld(&bar[XB_XCNT(j)]); sum += c; cnt += (c > 0u) ? 1u : 0u; mine = (j == x) ? c : mine; }
        if (sum == G) break;
        __builtin_amdgcn_s_sleep(1);
        if ((++sp & 255u) == 0u) { if (xb_ld(&bar[XB_TMO])) break; if (sp > XB_SPIN_CAP) { atomicAdd(&bar[XB_TMO], 1u); break; } }
    }
    nloc = mine > 0u ? mine : 1u; nx = cnt > 0u ? cnt : 1u;
}
__device__ __forceinline__ void xcd_barrier(unsigned* bar, unsigned x, volatile LAS unsigned* st, unsigned G, int tid) {
    asm volatile("s_waitcnt vmcnt(0)" ::: "memory");
    __syncthreads();
    if (tid == 0) {
        __builtin_amdgcn_s_waitcnt(0);
        unsigned nloc = st[0], nx = st[1];
        if (nloc == 0u) { xcd_barrier_complete(bar, x, G, nloc, nx); st[0] = nloc; st[1] = nx; }
        const unsigned old = xb_add(&bar[XB_XSUB(x)], 1u);
        const unsigned gen = old / nloc;
        if (old + 1u == (gen + 1u) * nloc) {
            __builtin_amdgcn_fence(__ATOMIC_RELEASE, "agent");
            asm volatile("s_waitcnt vmcnt(0)" ::: "memory");
            const unsigned og = xb_add(&bar[XB_TOP], 1u);
            const unsigned tg = og / nx;
            if (og + 1u == (tg + 1u) * nx) xb_add(&bar[XB_TOPGEN], 1u);
            else XB_SPIN(xb_ld(&bar[XB_TOPGEN]) == tg, bar);
            __builtin_amdgcn_fence(__ATOMIC_ACQUIRE, "agent");
            xb_add(&bar[XB_XGEN(x)], 1u);
            asm volatile("s_waitcnt vmcnt(0)" ::: "memory");
        } else {
            XB_SPIN(xb_ld(&bar[XB_XGEN(x)]) == gen, bar);
            __builtin_amdgcn_fence(__ATOMIC_ACQUIRE, "agent");
            asm volatile("s_waitcnt vmcnt(0)" ::: "memory");
        }
    }
    __syncthreads();
}

struct SchedStd {
    StaticOrder so; const char* A; const char* B; size_t ta, tb;
    __device__ __forceinline__ bool next(int i, Unit& u) const { return so.next(i, u); }
    __device__ __forceinline__ void ptrs(const Unit& u, const char*& a, const char*& b) const { a = A + (size_t)u.pm * ta; b = B + (size_t)u.pn * tb; }
};
struct SchedIn {
    int c; const char* XG; const char* W;
    __device__ __forceinline__ bool next(int i, Unit& u) const { if (i >= 3) return false; const int x = c & 7, j = c >> 3, jj = j & 7, ct = j >> 3; u.pn = ct;
        if (jj < 4) { u.pm = 8 * x + jj + (i == 1 ? 4 : 0); u.ty = i == 0 ? 0 : (i == 1 ? 3 : 1); }
        else        { u.pm = 8 * x + jj - (i == 2 ? 4 : 0); u.ty = i == 0 ? 1 : 2; }
        return true; }
    __device__ __forceinline__ void ptrs(const Unit& u, const char*& a, const char*& b) const {
        const int wt = (u.ty == 1 ? 4 : (u.ty == 2 ? 8 : 0)) + u.pn;
        const char* xa = XG + (size_t)u.pm * (size_t)(256 * DM * 2); const char* wb = W + (size_t)wt * (size_t)(256 * DM * 2);
        if (u.ty == 1) { a = xa; b = wb; } else { a = wb; b = xa; }
    }
};
typedef f32x4 Acc[2][2][4][2];

struct EpiIn {
    static constexpr bool PERM = true;
    bf16_t* AT; bf16_t* U; bf16_t* VT; const float* rstd; float* ya;
    __device__ __forceinline__ void operator()(const Acc& acc, const Unit& u, int wr, int wc, int fr_, int fq_) const {
        int fr = fr_, fq = fq_; asm volatile("" : "+v"(fr), "+v"(fq));
        if (u.ty == 1) {
            const int row0 = u.pm * BM + wr * 64 + fr, col0 = u.pn * BM + wc * 32 + 8 * fq;
#pragma unroll
            for (int ai = 0; ai < 2; ++ai)
#pragma unroll
                for (int m = 0; m < 4; ++m) { const int r = row0 + ai * HALF + m * 16; const float rs = rstd[r]; bf16_t* rowp = U + (size_t)r * FW + col0;
#pragma unroll
                    for (int bj = 0; bj < 2; ++bj) { f32x4 v0 = acc[ai][bj][m][0] * rs, v1 = acc[ai][bj][m][1] * rs;
                        *(u32x4*)(rowp + bj * HALF) = pack8(v0, v1); } }
        } else {
            const int col0 = u.pm * BM + wc * 32 + 8 * fq;
            f32x4 rs[2][2];
#pragma unroll
            for (int bj = 0; bj < 2; ++bj)
#pragma unroll
                for (int n = 0; n < 2; ++n) rs[bj][n] = *(const f32x4*)(rstd + col0 + bj * HALF + 4 * n);
            if (u.ty == 2) {
#pragma unroll
                for (int ai = 0; ai < 2; ++ai)
#pragma unroll
                    for (int m = 0; m < 4; ++m) { const int hh = u.pn * 2 + ai, dd = wr * 64 + m * 16 + fr;
                        const int r5 = dd & 31, frag = (((wc * 4 + (dd >> 5)) * 2 + ((r5 >> 2) & 1)) * 64 + fq * 16 + (r5 >> 3) * 4 + (r5 & 3)) * 8;
#pragma unroll
                        for (int bj = 0; bj < 2; ++bj) { f32x4 v0 = gelu4(acc[ai][bj][m][0] * rs[bj][0]), v1 = gelu4(acc[ai][bj][m][1] * rs[bj][1]);
                            *(u32x4*)(VT + (size_t)((u.pm * 2 + bj) * 8 + hh) * 16384 + frag) = pack8(v0, v1); } }
            } else {
                const int b = u.pm >> 3, s0 = (u.pm & 7) * BM + wc * 32 + 8 * fq;
#pragma unroll
                for (int ai = 0; ai < 2; ++ai)
#pragma unroll
                    for (int m = 0; m < 4; ++m) { const int n = (b * 8 + u.pn * 2 + ai) * 128 + wr * 64 + m * 16 + fr; bf16_t* rowp = AT + (size_t)n * SEQ + s0; float t = 0.f;
#pragma unroll
                        for (int bj = 0; bj < 2; ++bj) { const f32x4 a0 = acc[ai][bj][m][0] * rs[bj][0], a1 = acc[ai][bj][m][1] * rs[bj][1];
                            t += ((a0[0] - a0[1]) + (a0[2] - a0[3])) + ((a1[0] - a1[1]) + (a1[2] - a1[3]));
                            if (u.ty == 0) *(u32x4*)(rowp + bj * HALF) = pack8(a0, a1);
                            else { const u32x4 pw = *(const u32x4*)(rowp - 1024 + bj * HALF); f32x4 p0, p1;
                                p0[0] = __builtin_bit_cast(float, pw.x << 16); p0[1] = __builtin_bit_cast(float, pw.x & 0xffff0000u); p0[2] = __builtin_bit_cast(float, pw.y << 16); p0[3] = __builtin_bit_cast(float, pw.y & 0xffff0000u);
                                p1[0] = __builtin_bit_cast(float, pw.z << 16); p1[1] = __builtin_bit_cast(float, pw.z & 0xffff0000u); p1[2] = __builtin_bit_cast(float, pw.w << 16); p1[3] = __builtin_bit_cast(float, pw.w & 0xffff0000u);
                                *(u32x4*)(rowp - 1024 + bj * HALF) = pack8(p0 + a0, p1 + a1);
                                *(u32x4*)(rowp + bj * HALF) = pack8(p0 - a0, p1 - a1); } }
                        t += __shfl_xor(t, 16); t += __shfl_xor(t, 32);
                        if (fq == 0) unsafeAtomicAdd(ya + n, t); }
            }
        }
    }
};
struct SchedPair {
    int w, NW; const char* D; const char* B;
    __device__ __forceinline__ bool next(int i, Unit& u) const { const int pi = w + (i >> 1) * NW; if (pi >= 128) return false; const int x = pi & 7, j = pi >> 3; u.pm = j & 3; u.pn = x * 4 + (j >> 2); u.ty = i & 1; return true; }
    __device__ __forceinline__ void ptrs(const Unit& u, const char*& a, const char*& b) const { a = D + (size_t)u.pm * (256 * 2048 * 2) + u.ty * 2048; b = B + (size_t)u.pn * (256 * 2048 * 2) + (u.pm >> 1) * 2048; }
};
struct EpiDftZ {
    static constexpr bool PERM = true;
    bf16_t* Z;
    __device__ __forceinline__ void operator()(const Acc& acc, const Unit& u, int wr, int wc, int fr_, int fq_) const {
        int fr = fr_, fq = fq_; asm volatile("" : "+v"(fr), "+v"(fq));
        bf16_t* zb = Z + (size_t)(u.pn * 4 + u.pm) * (2 * 256 * 256) + u.ty * 128 + wc * 32 + 8 * fq;
#pragma unroll
        for (int ai = 0; ai < 2; ++ai)
#pragma unroll
            for (int m = 0; m < 4; ++m) { const int r = ai * HALF + wr * 64 + m * 16 + fr;
#pragma unroll
                for (int bj = 0; bj < 2; ++bj) *(u32x4*)(zb + (size_t)(bj * 256 + r) * 256) = pack8(acc[ai][bj][m][0], acc[ai][bj][m][1]); }
    }
};
struct SchedPost {
    int w, NW; const char* Z; const char* GP;
    __device__ __forceinline__ bool next(int i, Unit& u) const { const int pi = w + (i >> 1) * NW; if (pi >= 128) return false; const int x = pi & 7, j = pi >> 3; u.pm = j & 3; u.pn = x * 4 + (j >> 2); u.ty = i & 1; return true; }
    __device__ __forceinline__ void ptrs(const Unit& u, const char*& a, const char*& b) const { a = Z + (size_t)((u.pn * 4 + u.pm) * 2 + u.ty) * (256 * 256 * 2); b = GP + (size_t)((u.pn & 3) * 2 + u.ty) * (256 * 256 * 2); }
};
struct EpiPost {
    static constexpr bool PERM = true;
    bf16_t* MIX;
    __device__ __forceinline__ void operator()(const Acc& acc, const Unit& u, int wr, int wc, int fr_, int fq_) const {
        int fr = fr_, fq = fq_; asm volatile("" : "+v"(fr), "+v"(fq));
        const int b = u.pn >> 2, col0 = ((u.pn & 3) * 2 + u.ty) * 128 + wc * 32 + 8 * fq;
#pragma unroll
        for (int ai = 0; ai < 2; ++ai)
#pragma unroll
            for (int m = 0; m < 4; ++m) { const int rr = (u.pm & 1) * BM + ai * HALF + wr * 64 + m * 16 + fr, k = 2 * rr + (u.pm >> 1);
                *(u32x4*)(MIX + (size_t)(b * SEQ + k) * DM + col0) = pack8(acc[ai][0][m][0], acc[ai][0][m][1]);
                if (k != 0) *(u32x4*)(MIX + (size_t)(b * SEQ + SEQ - k) * DM + col0) = pack8(acc[ai][1][m][0], acc[ai][1][m][1]); }
    }
};
struct EpiOut {
    static constexpr bool PERM = true;
    bf16_t* XGH; const float* igmix; const float* gmlp; float* ss;
    __device__ __forceinline__ void operator()(const Acc& acc, const Unit& u, int wr, int wc, int fr, int fq) const {
        const int row0 = u.pm * BM + wr * 64 + fr, col0 = u.pn * BM + wc * 32 + 8 * fq;
#pragma unroll
        for (int ai = 0; ai < 2; ++ai)
#pragma unroll
            for (int m = 0; m < 4; ++m) { const int r = row0 + ai * HALF + m * 16; const size_t o = (size_t)r * DM + col0; float s = 0.f;
#pragma unroll
                for (int bj = 0; bj < 2; ++bj) {
                    const u32x4 xw = *(const u32x4*)(XGH + o + bj * HALF);
                    const f32x4 i0 = *(const f32x4*)(igmix + col0 + bj * HALF), i1 = *(const f32x4*)(igmix + col0 + bj * HALF + 4), g0 = *(const f32x4*)(gmlp + col0 + bj * HALF), g1 = *(const f32x4*)(gmlp + col0 + bj * HALF + 4);
                    f32x4 x0, x1;
                    x0[0] = __builtin_bit_cast(float, xw.x << 16); x0[1] = __builtin_bit_cast(float, xw.x & 0xffff0000u); x0[2] = __builtin_bit_cast(float, xw.y << 16); x0[3] = __builtin_bit_cast(float, xw.y & 0xffff0000u);
                    x1[0] = __builtin_bit_cast(float, xw.z << 16); x1[1] = __builtin_bit_cast(float, xw.z & 0xffff0000u); x1[2] = __builtin_bit_cast(float, xw.w << 16); x1[3] = __builtin_bit_cast(float, xw.w & 0xffff0000u);
                    const f32x4 h0 = acc[ai][bj][m][0] + x0 * i0, h1 = acc[ai][bj][m][1] + x1 * i1;
                    s += (h0[0] * h0[0] + h0[1] * h0[1]) + (h0[2] * h0[2] + h0[3] * h0[3]) + (h1[0] * h1[0] + h1[1] * h1[1]) + (h1[2] * h1[2] + h1[3] * h1[3]);
                    *(u32x4*)(XGH + o + bj * HALF) = pack8(h0 * g0, h1 * g1);
                }
                s += __shfl_xor(s, 16); s += __shfl_xor(s, 32);
                if (fq == 0) unsafeAtomicAdd(ss + r, s);
            }
    }
};
struct EpiUp {
    static constexpr bool PERM = true;
    bf16_t* ACT;
    __device__ __forceinline__ void operator()(const Acc& acc, const Unit& u, int wr, int wc, int fr, int fq) const {
#pragma unroll
        for (int ai = 0; ai < 2; ++ai)
#pragma unroll
            for (int m = 0; m < 4; ++m) { const int R = ai * HALF + wr * 64 + m * 16 + fr;
                bf16_t* rowp = ACT + ((size_t)(u.pm * 128 + u.pn * 4 + (wc >> 1)) * 256 + R) * 64 + (wc & 1) * 32 + 8 * fq;
#pragma unroll
                for (int bj = 0; bj < 2; ++bj) { f32x4 v0 = acc[ai][bj][m][0], v1 = acc[ai][bj][m][1];
#pragma unroll
                    for (int j = 0; j < 4; ++j) { v0[j] = fmaxf(v0[j], 0.f); v0[j] *= v0[j]; v1[j] = fmaxf(v1[j], 0.f); v1[j] *= v1[j]; }
                    *(u32x4*)(rowp + bj * (2 * 256 * 64)) = pack8(v0, v1); } }
    }
};

struct EpiDown {
    static constexpr bool PERM = true;
    bf16_t* HGH; const float* igmlp; const float* ssin; float* ss;
    __device__ __forceinline__ void operator()(const Acc& acc, const Unit& u, int wr, int wc, int fr, int fq) const {
        const int row0 = u.pm * BM + wr * 64 + fr, col0 = u.pn * BM + wc * 32 + 8 * fq;
#pragma unroll
        for (int ai = 0; ai < 2; ++ai)
#pragma unroll
            for (int m = 0; m < 4; ++m) { const int r = row0 + ai * HALF + m * 16; const size_t o = (size_t)r * DM + col0; float s = 0.f;
                const float rs2 = __builtin_amdgcn_rcpf(ssin[r] * (1.0f / DM) + EPS);
#pragma unroll
                for (int bj = 0; bj < 2; ++bj) {
                    const u32x4 xw = *(const u32x4*)(HGH + o + bj * HALF);
                    const f32x4 i0 = *(const f32x4*)(igmlp + col0 + bj * HALF), i1 = *(const f32x4*)(igmlp + col0 + bj * HALF + 4);
                    f32x4 x0, x1;
                    x0[0] = __builtin_bit_cast(float, xw.x << 16); x0[1] = __builtin_bit_cast(float, xw.x & 0xffff0000u); x0[2] = __builtin_bit_cast(float, xw.y << 16); x0[3] = __builtin_bit_cast(float, xw.y & 0xffff0000u);
                    x1[0] = __builtin_bit_cast(float, xw.z << 16); x1[1] = __builtin_bit_cast(float, xw.z & 0xffff0000u); x1[2] = __builtin_bit_cast(float, xw.w << 16); x1[3] = __builtin_bit_cast(float, xw.w & 0xffff0000u);
                    const f32x4 h0 = acc[ai][bj][m][0] * rs2 + x0 * i0, h1 = acc[ai][bj][m][1] * rs2 + x1 * i1;
                    s += (h0[0] * h0[0] + h0[1] * h0[1]) + (h0[2] * h0[2] + h0[3] * h0[3]) + (h1[0] * h1[0] + h1[1] * h1[1]) + (h1[2] * h1[2] + h1[3] * h1[3]);
                    *(u32x4*)(HGH + o + bj * HALF) = pack8(h0, h1);
                }
                s += __shfl_xor(s, 16); s += __shfl_xor(s, 32);
                if (fq == 0) unsafeAtomicAdd(ss + r, s);
            }
    }
};

struct SchedFinal {
    int c; const char* A; const char* B;
    __device__ __forceinline__ bool next(int i, Unit& u) const { if (i >= 2) return false; const int x = c & 7, j = c >> 3; u.pm = i * 32 + x * 4 + (j >> 3); u.pn = j & 7; u.ty = 0; return true; }
    __device__ __forceinline__ void ptrs(const Unit& u, const char*& a, const char*& b) const { a = A + (size_t)u.pm * ((size_t)256 * DFF * 2); b = B + (size_t)u.pn * ((size_t)256 * DFF * 2); }
};
struct EpiFinal {
    static constexpr bool PERM = true;
    const bf16_t* HGH; const float* igmlp; const float* ssin; float* ss; unsigned* pcnt; const float* gfin; float* out;
    __device__ __forceinline__ void operator()(Acc& acc, const Unit& u, int wr, int wc, int fr_, int fq_) const {
        int fr = fr_, fq = fq_; asm volatile("" : "+v"(fr), "+v"(fq));
        const int row0 = u.pm * BM + wr * 64 + fr, col0 = u.pn * BM + wc * 32 + 8 * fq;
#pragma unroll
        for (int ai = 0; ai < 2; ++ai)
#pragma unroll
            for (int m = 0; m < 4; ++m) { const int r = row0 + ai * HALF + m * 16; const size_t o = (size_t)r * DM + col0; float s = 0.f;
                const float rs2 = __builtin_amdgcn_rcpf(ssin[r] * (1.0f / DM) + EPS);
#pragma unroll
                for (int bj = 0; bj < 2; ++bj) {
                    const u32x4 xw = *(const u32x4*)(HGH + o + bj * HALF);
                    const f32x4 i0 = *(const f32x4*)(igmlp + col0 + bj * HALF), i1 = *(const f32x4*)(igmlp + col0 + bj * HALF + 4);
                    f32x4 x0, x1;
                    x0[0] = __builtin_bit_cast(float, xw.x << 16); x0[1] = __builtin_bit_cast(float, xw.x & 0xffff0000u); x0[2] = __builtin_bit_cast(float, xw.y << 16); x0[3] = __builtin_bit_cast(float, xw.y & 0xffff0000u);
                    x1[0] = __builtin_bit_cast(float, xw.z << 16); x1[1] = __builtin_bit_cast(float, xw.z & 0xffff0000u); x1[2] = __builtin_bit_cast(float, xw.w << 16); x1[3] = __builtin_bit_cast(float, xw.w & 0xffff0000u);
                    const f32x4 h0 = acc[ai][bj][m][0] * rs2 + x0 * i0, h1 = acc[ai][bj][m][1] * rs2 + x1 * i1;
                    s += (h0[0] * h0[0] + h0[1] * h0[1]) + (h0[2] * h0[2] + h0[3] * h0[3]) + (h1[0] * h1[0] + h1[1] * h1[1]) + (h1[2] * h1[2] + h1[3] * h1[3]);
                    acc[ai][bj][m][0] = h0; acc[ai][bj][m][1] = h1;
                }
                s += __shfl_xor(s, 16); s += __shfl_xor(s, 32);
                if (fq == 0) unsafeAtomicAdd(ss + r, s);
            }
        asm volatile("s_waitcnt vmcnt(0)" ::: "memory");
        unsigned* pc = pcnt + 64 * u.pm;
        if (fr == 0 && fq == 0) __hip_atomic_fetch_add(pc, 1u, __ATOMIC_RELAXED, __HIP_MEMORY_SCOPE_AGENT);
        { unsigned sp = 0; while ((unsigned)__builtin_amdgcn_readfirstlane((int)__hip_atomic_load(pc, __ATOMIC_RELAXED, __HIP_MEMORY_SCOPE_AGENT)) < 64u) { __builtin_amdgcn_s_sleep(1); if (++sp > (1u << 20)) break; } }
#pragma unroll
        for (int ai = 0; ai < 2; ++ai)
#pragma unroll
            for (int m = 0; m < 4; ++m) { const int r = row0 + ai * HALF + m * 16; const size_t o = (size_t)r * DM + col0;
                const float rs = 1.0f / sqrtf(__hip_atomic_load(ss + r, __ATOMIC_RELAXED, __HIP_MEMORY_SCOPE_AGENT) * (1.0f / DM) + EPS);
#pragma unroll
                for (int bj = 0; bj < 2; ++bj) {
                    const f32x4 g0 = *(const f32x4*)(gfin + col0 + bj * HALF), g1 = *(const f32x4*)(gfin + col0 + bj * HALF + 4);
                    *(f32x4*)(out + o + bj * HALF) = acc[ai][bj][m][0] * rs * g0; *(f32x4*)(out + o + bj * HALF + 4) = acc[ai][bj][m][1] * rs * g1;
                }
            }
    }
};

template <class Epi, class Sched, bool ALIGN_EPI, bool SP2>
__device__ __forceinline__ void gemm_phase(LAS unsigned char* lds, const Gemm g, const Sched& S, const Epi& E, const int wid) {
    const int lane = lane_id();
    const int tid = wid * 64 + lane, wr = wid >> 2, wc = wid & 3, fr = lane & 15, fq = lane >> 4;
    const int K = g.K, nt = K / BK;
    unsigned voffA[2], voffB[2];
#pragma unroll
    for (int i = 0; i < 2; ++i) { int R, C; stage_rc(tid * 16 + i * 8192, R, C); const int Rb = Epi::PERM ? ((R & ~31) + perm32(R & 31)) : R;
        voffA[i] = (unsigned)(R * g.lda + C) * 2u; voffB[i] = (unsigned)(Rb * g.ldb + C) * 2u; }
    const size_t ksA = (size_t)g.ksA, ksB = (size_t)g.ksB;
    const size_t hstepA = (size_t)HALF * g.lda * 2, hstepB = (size_t)HALF * g.ldb * 2;
    const unsigned ldsw = (unsigned)wid * 1024u;
    const int aoff = lds_byte(wr * 64 + fr, fq * 8), boff = lds_byte(wc * 32 + fr, fq * 8);
#define PG8_SA(b, h) (((b) * 2 + (h)) * HTB)
#define PG8_SB(b, h) ((4 + (b) * 2 + (h)) * HTB)
#define PG8_STAGE(bufoff, gbase, voff) do { _Pragma("unroll") for (int _i = 0; _i < 2; ++_i) \
        __builtin_amdgcn_global_load_lds((const unsigned*)((const char*)(gbase) + (voff)[_i]), (LAS unsigned*)(lds + (bufoff) + ldsw + _i * 8192), 16, 0, 0); } while (0)
#define PG8_LDA(dst, b, h) do { _Pragma("unroll") for (int m = 0; m < 4; ++m) _Pragma("unroll") for (int k = 0; k < 2; ++k) dst[m][k] = *(const LAS bf16x8*)(lds + PG8_SA(b, h) + aoff + m * 2048 + k * 1024); } while (0)
#define PG8_LDB(dst, b, h) do { _Pragma("unroll") for (int n = 0; n < 2; ++n) _Pragma("unroll") for (int k = 0; k < 2; ++k) dst[n][k] = *(const LAS bf16x8*)(lds + PG8_SB(b, h) + boff + n * 2048 + k * 1024); } while (0)
#define PG8_MMA(ai, bj, At, Bt) do { __builtin_amdgcn_s_setprio(1); _Pragma("unroll") for (int m = 0; m < 4; ++m) _Pragma("unroll") for (int n = 0; n < 2; ++n) _Pragma("unroll") for (int k = 0; k < 2; ++k) \
        acc[ai][bj][m][n] = __builtin_amdgcn_mfma_f32_16x16x32_bf16(Bt[n][k], At[m][k], acc[ai][bj][m][n], 0, 0, 0); __builtin_amdgcn_s_setprio(0); } while (0)
#define PG8_WAIT_V(n) asm volatile("s_waitcnt vmcnt(" #n ")" ::: "memory")
#define PG8_WAIT_L(n) asm volatile("s_waitcnt lgkmcnt(" #n ")" ::: "memory")
#define PG8_BAR __builtin_amdgcn_s_barrier()
#define PG8_SCHED __builtin_amdgcn_sched_barrier(0)
    Unit cur, nxt; int ui = 0;
    if (!S.next(0, cur)) return;
    Acc acc;
#pragma unroll
    for (int a = 0; a < 2; ++a)
#pragma unroll
        for (int b = 0; b < 2; ++b)
#pragma unroll
            for (int m = 0; m < 4; ++m)
#pragma unroll
                for (int n = 0; n < 2; ++n) acc[a][b][m][n] = (f32x4){0.f, 0.f, 0.f, 0.f};
    bf16x8 At[4][2], B0[2][2], B1[2][2];
    const char* cA; const char* cB; S.ptrs(cur, cA, cB);
    if constexpr (SP2) {
        PG8_STAGE(PG8_SB(0, 0), cB, voffB); PG8_STAGE(PG8_SB(0, 1), cB + hstepB, voffB); PG8_STAGE(PG8_SA(0, 0), cA, voffA); PG8_STAGE(PG8_SA(0, 1), cA + hstepA, voffA);
        if (wr == 1) PG8_BAR;
        PG8_WAIT_V(2); PG8_BAR;
        PG8_STAGE(PG8_SB(1, 0), cB + ksB, voffB); PG8_STAGE(PG8_SA(1, 0), cA + ksA, voffA); PG8_STAGE(PG8_SB(1, 1), cB + hstepB + ksB, voffB);
        PG8_WAIT_V(6); PG8_BAR;
    } else {
        PG8_STAGE(PG8_SB(0, 0), cB, voffB); PG8_STAGE(PG8_SA(0, 0), cA, voffA); PG8_STAGE(PG8_SB(0, 1), cB + hstepB, voffB); PG8_STAGE(PG8_SA(0, 1), cA + hstepA, voffA);
        if (wr == 1) PG8_BAR;
        PG8_WAIT_V(4); PG8_BAR;
        PG8_STAGE(PG8_SB(1, 0), cB + ksB, voffB); PG8_STAGE(PG8_SA(1, 0), cA + ksA, voffA); PG8_STAGE(PG8_SB(1, 1), cB + hstepB + ksB, voffB);
        PG8_WAIT_V(6); PG8_BAR;
    }
    for (;;) {
        const bool has_next = S.next(ui + 1, nxt);
        const char* nA = cA; const char* nB = cB; if (has_next) S.ptrs(nxt, nA, nB);
        for (int t = 0; t < nt; t += 2) {
            const bool last = (t == nt - 2);
            const char* a1 = cA + (size_t)(t + 1) * ksA;
            const char* a2 = last ? nA : cA + (size_t)(t + 2) * ksA; const char* b2 = last ? nB : cB + (size_t)(t + 2) * ksB;
            const char* a3 = a2 + ksA; const char* b3 = b2 + ksB;
            if constexpr (SP2) {
            PG8_LDB(B0, 0, 0); PG8_LDB(B1, 0, 1); PG8_SCHED; PG8_LDA(At, 0, 0); PG8_STAGE(PG8_SA(1, 1), a1 + hstepA, voffA);
            PG8_WAIT_V(8); PG8_WAIT_L(0); PG8_BAR; PG8_MMA(0, 0, At, B0); PG8_MMA(0, 1, At, B1); PG8_BAR; PG8_SCHED;
            PG8_LDA(At, 0, 1); PG8_STAGE(PG8_SB(0, 0), b2, voffB); PG8_STAGE(PG8_SB(0, 1), b2 + hstepB, voffB); PG8_STAGE(PG8_SA(0, 0), a2, voffA);
            PG8_WAIT_V(8); PG8_WAIT_L(0); PG8_BAR; PG8_MMA(1, 0, At, B0); PG8_MMA(1, 1, At, B1); PG8_BAR; PG8_SCHED;
            PG8_LDB(B0, 1, 0); PG8_LDB(B1, 1, 1); PG8_SCHED; PG8_LDA(At, 1, 0); PG8_STAGE(PG8_SA(0, 1), a2 + hstepA, voffA);
            PG8_WAIT_V(8); PG8_WAIT_L(0); PG8_BAR; PG8_MMA(0, 0, At, B0); PG8_MMA(0, 1, At, B1); PG8_BAR; PG8_SCHED;
            PG8_LDA(At, 1, 1); PG8_STAGE(PG8_SB(1, 0), b3, voffB); PG8_STAGE(PG8_SB(1, 1), b3 + hstepB, voffB); PG8_STAGE(PG8_SA(1, 0), a3, voffA);
            PG8_WAIT_V(8); PG8_WAIT_L(0); PG8_BAR; PG8_MMA(1, 0, At, B0); PG8_MMA(1, 1, At, B1); PG8_BAR; PG8_SCHED;
            } else {
            PG8_LDB(B0, 0, 0); PG8_SCHED; PG8_LDA(At, 0, 0); PG8_STAGE(PG8_SA(1, 1), a1 + hstepA, voffA);
            PG8_WAIT_L(8); PG8_BAR; PG8_WAIT_L(0); PG8_MMA(0, 0, At, B0); PG8_BAR; PG8_SCHED;
            PG8_LDB(B1, 0, 1); PG8_STAGE(PG8_SB(0, 0), b2, voffB);
            PG8_BAR; PG8_WAIT_L(0); PG8_MMA(0, 1, At, B1); PG8_BAR;
            PG8_LDA(At, 0, 1); PG8_STAGE(PG8_SA(0, 0), a2, voffA);
            PG8_BAR; PG8_WAIT_L(0); PG8_MMA(1, 0, At, B0); PG8_BAR; PG8_SCHED;
            PG8_STAGE(PG8_SB(0, 1), b2 + hstepB, voffB);
            PG8_WAIT_V(6); PG8_BAR; PG8_MMA(1, 1, At, B1); PG8_BAR;
            PG8_LDB(B0, 1, 0); PG8_SCHED; PG8_LDA(At, 1, 0); PG8_STAGE(PG8_SA(0, 1), a2 + hstepA, voffA);
            PG8_WAIT_L(8); PG8_BAR; PG8_WAIT_L(0); PG8_MMA(0, 0, At, B0); PG8_BAR; PG8_SCHED;
            PG8_LDB(B1, 1, 1); PG8_STAGE(PG8_SB(1, 0), b3, voffB);
            PG8_BAR; PG8_WAIT_L(0); PG8_MMA(0, 1, At, B1); PG8_BAR;
            PG8_LDA(At, 1, 1); PG8_STAGE(PG8_SA(1, 0), a3, voffA);
            PG8_BAR; PG8_WAIT_L(0); PG8_MMA(1, 0, At, B0); PG8_BAR; PG8_SCHED;
            PG8_STAGE(PG8_SB(1, 1), b3 + hstepB, voffB);
            PG8_WAIT_V(6); PG8_BAR; PG8_MMA(1, 1, At, B1); PG8_BAR;
            }
        }
        if constexpr (ALIGN_EPI) { if (wr == 0) PG8_BAR; }
        E(acc, cur, wr, wc, fr, fq);
        if (!has_next) break;
#pragma unroll
        for (int a = 0; a < 2; ++a)
#pragma unroll
            for (int b = 0; b < 2; ++b)
#pragma unroll
                for (int m = 0; m < 4; ++m)
#pragma unroll
                    for (int n = 0; n < 2; ++n) acc[a][b][m][n] = (f32x4){0.f, 0.f, 0.f, 0.f};
        cur = nxt; cA = nA; cB = nB; ++ui;
        if constexpr (ALIGN_EPI) { if (wr == 1) PG8_BAR; }
    }
    PG8_WAIT_V(0);
    if constexpr (!ALIGN_EPI) { if (wr == 0) PG8_BAR; }
    PG8_BAR;
#undef PG8_SA
#undef PG8_SB
#undef PG8_STAGE
#undef PG8_LDA
#undef PG8_LDB
#undef PG8_MMA
#undef PG8_WAIT_V
#undef PG8_WAIT_L
#undef PG8_BAR
#undef PG8_SCHED
}

#define LDS_WAIT() asm volatile("s_waitcnt lgkmcnt(0)" ::: "memory")
__device__ __forceinline__ float wave_sum(float v) {
#pragma unroll
    for (int o = 1; o < 64; o <<= 1) v += __shfl_xor(v, o);
    return v;
}
__device__ __forceinline__ void tr_load(f32x4 (&v)[16], const float* W, int N, int item, int lane) {
    const int nblk = N >> 6, kb = item / nblk, nb = item - kb * nblk, k0 = kb << 6, n0 = nb << 6, lr = lane >> 4, lc = lane & 15;
    const float* src = W + (size_t)k0 * N + n0 + 4 * lc;
#pragma unroll
    for (int i = 0; i < 16; ++i) { const int kk = 8 * (i >> 1) + 2 * lr + (i & 1); v[i] = __builtin_nontemporal_load((const f32x4*)(src + (size_t)kk * N)); }
}
__device__ __forceinline__ void tr_store(const f32x4 (&v)[16], int K, int N, bf16_t* WT, LAS unsigned char* scr, int item, int lane_) {
    int lane = lane_; asm volatile("" : "+v"(lane));
    const int nblk = N >> 6, kb = item / nblk, nb = item - kb * nblk, k0 = kb << 6, n0 = nb << 6, lr = lane >> 4, lc = lane & 15;
#pragma unroll
    for (int ip = 0; ip < 8; ++ip)
#pragma unroll
        for (int e = 0; e < 4; ++e) *(LAS unsigned*)(scr + (4 * lc + e) * 128 + ((ip ^ (lc & 7)) << 4) + 4 * lr) = cvt_pk_bf16(v[2 * ip][e], v[2 * ip + 1][e]);
    LDS_WAIT(); asm volatile("" ::: "memory");
    const int c = lane & 7;
#pragma unroll
    for (int j = 0; j < 8; ++j) { const int n = (lane >> 3) + 8 * j;
        const u32x4 o = *(const LAS u32x4*)(scr + n * 128 + ((c ^ ((n >> 2) & 7)) << 4));
        *(u32x4*)(WT + (size_t)(n0 + n) * K + k0 + 8 * c) = o; }
    LDS_WAIT(); asm volatile("" ::: "memory");
}
__device__ __forceinline__ void p0_transpose_item(const float* W, int K, int N, bf16_t* WT, LAS unsigned char* scr, int item, int lane) {
    f32x4 v[16]; tr_load(v, W, N, item, lane); tr_store(v, K, N, WT, scr, item, lane);
}

struct Args { const float* in[12]; float* out; unsigned char* ws; };

__global__ void __launch_bounds__(512, 2) fwd_megakernel(Args args) {
    extern __shared__ __attribute__((aligned(16))) unsigned char lds_raw[];
    LAS unsigned char* lds = (LAS unsigned char*)lds_raw;
    cg::grid_group grid = cg::this_grid();
    const int tid = threadIdx.x, lane = tid & 63, wave = __builtin_amdgcn_readfirstlane(tid >> 6);
    const int G = gridDim.x, bx = blockIdx.x;
    unsigned char* ws = args.ws;
    const float* x = args.in[0]; const float* g_mix = args.in[1]; const float* w_in = args.in[2]; const float* w_f = args.in[3];
    const float* g_v = args.in[4]; const float* w_s = args.in[5]; const float* b_s = args.in[6]; const float* w_out = args.in[7];
    const float* g_mlp = args.in[8]; const float* w_up = args.in[9]; const float* w_dn = args.in[10]; const float* g_fin = args.in[11];
    float* out = args.out;
    unsigned* gbar = (unsigned*)(ws + WS_BAR); unsigned* pcnt = (unsigned*)(ws + WS_PCNT); float* ya = (float*)(ws + WS_YA); float* igmix = (float*)(ws + WS_IGMIX); float* igmlp = (float*)(ws + WS_IGMLP);
    float* rstd_x = (float*)(ws + WS_RSX); float* ss_h = (float*)(ws + WS_SSH); float* ss_h2 = (float*)(ws + WS_SSH2);
    bf16_t* GT = (bf16_t*)(ws + WS_GT); bf16_t* WIN = (bf16_t*)(ws + WS_WIN); bf16_t* WOUT = (bf16_t*)(ws + WS_WOUT);
    bf16_t* WUP = (bf16_t*)(ws + WS_WUP); bf16_t* WDN = (bf16_t*)(ws + WS_WDN); bf16_t* DFT = (bf16_t*)(ws + WS_DFT);
    bf16_t* XG = (bf16_t*)(ws + WS_XG); bf16_t* PF = (bf16_t*)(ws + WS_PF); bf16_t* U = (bf16_t*)(ws + WS_U); bf16_t* VT = (bf16_t*)(ws + WS_VT);
    bf16_t* B12 = (bf16_t*)(ws + WS_B12); bf16_t* MIX = (bf16_t*)(ws + WS_MIX); bf16_t* ACT = (bf16_t*)(ws + WS_ACT);

    volatile LAS unsigned* xst = (volatile LAS unsigned*)(lds + 131072 + 1024);
    if (tid == 0) { xst[0] = 0u; xst[1] = 0u; }
    const unsigned xcc = xb_xcc_id();
    for (int i = bx * 512 + tid; i < XCD_BAR_WORDS; i += G * 512) gbar[i] = 0u;
    grid.sync();
    if (tid == 0) (void)xb_add(&gbar[XB_XCNT(xcc)], 1u);
    {
        const int gw = bx * 8 + wave, NGW = G * 8, gt = bx * 512 + tid, NGT = G * 512;
        for (int i = gt; i < MT; i += NGT) { ss_h[i] = 0.f; ss_h2[i] = 0.f; if (i < NB * FW) ya[i] = 0.f; if (i < DM) { igmix[i] = 1.0f / g_mix[i]; igmlp[i] = 1.0f / g_mlp[i]; } if (i < 64 * 64) pcnt[i] = 0u; }
        for (int vb = bx; vb < 256; vb += G) {
            const int g = vb >> 5, sub = vb & 31;
            LAS float* wl = (LAS float*)lds;
#pragma unroll
            for (int i = 0; i < 8; ++i) ((LAS f32x4*)wl)[tid + 512 * i] = ((const f32x4*)(w_f + (size_t)g * 16384))[tid + 512 * i];
            __syncthreads();
            const int d = tid & 127, p = sub * 8 + (tid >> 7) * 2, cs = p >> 7, c = p & 127;
            float a0 = 0.f, a1 = 0.f;
#pragma unroll 8
            for (int j = 0; j < 128; ++j) { const float w = wl[j * 128 + d];
                const float p0 = (float)((c * j) & 127) * (1.0f / 128.0f), p1 = (float)(((c + 1) * j) & 127) * (1.0f / 128.0f);
                const float t0 = cs ? -__builtin_amdgcn_sinf(p0) : __builtin_amdgcn_cosf(p0), t1 = cs ? -__builtin_amdgcn_sinf(p1) : __builtin_amdgcn_cosf(p1);
                a0 += t0 * w; a1 += t1 * w; }
            { const float v0 = a0 * (1.0f / 512.0f), v1 = a1 * (1.0f / 512.0f);
              *(unsigned*)(GT + (size_t)g * 65536 + (size_t)d * 256 + cs * 128 + c) = cvt_pk_bf16(v0, v1);
              *(unsigned*)(GT + (size_t)g * 65536 + (size_t)(128 + d) * 256 + cs * 128 + c) = cs ? cvt_pk_bf16(-v0, -v1) : cvt_pk_bf16(v0, v1); }
            __syncthreads();
        }
        LAS unsigned char* scr = lds + wave * 16384;
        constexpr int I_IN = (DM / 64) * (NIN / 64), I_OUT = (DM / 64) * (DM / 64);
        for (int it = gw; it < I_IN + I_OUT; it += NGW) { if (it < I_IN) p0_transpose_item(w_in, DM, NIN, WIN, scr, it, lane); else p0_transpose_item(w_out, DM, DM, WOUT, scr, it - I_IN, lane); }
        for (int m = 2 * gw; m < MT; m += 2 * NGW) {
            const f32x4* xr = (const f32x4*)(x + (size_t)m * DM) + lane; const f32x4* gr = (const f32x4*)g_mix + lane;
            f32x4 v[2][8]; float s0 = 0.f, s1 = 0.f;
#pragma unroll
            for (int j = 0; j < 8; ++j) { v[0][j] = __builtin_nontemporal_load(xr + 64 * j); v[1][j] = __builtin_nontemporal_load(xr + 512 + 64 * j); }
#pragma unroll
            for (int j = 0; j < 8; ++j) { s0 += (v[0][j][0] * v[0][j][0] + v[0][j][1] * v[0][j][1]) + (v[0][j][2] * v[0][j][2] + v[0][j][3] * v[0][j][3]);
                                          s1 += (v[1][j][0] * v[1][j][0] + v[1][j][1] * v[1][j][1]) + (v[1][j][2] * v[1][j][2] + v[1][j][3] * v[1][j][3]); }
            s0 = wave_sum(s0); s1 = wave_sum(s1);
            if (lane == 0) { rstd_x[m] = 1.0f / sqrtf(s0 * (1.0f / DM) + EPS); rstd_x[m + 1] = 1.0f / sqrtf(s1 * (1.0f / DM) + EPS); }
            unsigned long long* o8 = (unsigned long long*)(XG + (size_t)m * DM) + lane;
#pragma unroll
            for (int j = 0; j < 8; ++j) { const f32x4 gg = gr[64 * j]; const f32x4 t0 = v[0][j] * gg, t1 = v[1][j] * gg;
                o8[64 * j] = (unsigned long long)cvt_pk_bf16(t0[0], t0[1]) | ((unsigned long long)cvt_pk_bf16(t0[2], t0[3]) << 32);
                o8[512 + 64 * j] = (unsigned long long)cvt_pk_bf16(t1[0], t1[1]) | ((unsigned long long)cvt_pk_bf16(t1[2], t1[3]) << 32); }
        }
        for (int q = gt; q < 1024 * 256; q += NGT) {
            const int r = q >> 8, col0 = (q & 255) * 8, cs = col0 >> 10, s0 = col0 & 1023, k = r < 512 ? 2 * r : 2 * (r - 512) + 1;
            float v[8];
#pragma unroll
            for (int j = 0; j < 8; ++j) { const float ph = (float)((k * (s0 + j)) & 2047) * (1.0f / 2048.0f); v[j] = cs ? __builtin_amdgcn_sinf(ph) : __builtin_amdgcn_cosf(ph); }
            u32x4 o; o.x = cvt_pk_bf16(v[0], v[1]); o.y = cvt_pk_bf16(v[2], v[3]); o.z = cvt_pk_bf16(v[4], v[5]); o.w = cvt_pk_bf16(v[6], v[7]);
            *(u32x4*)(DFT + (size_t)r * 2048 + col0) = o;
        }
    }
    xcd_barrier(gbar, xcc, xst, (unsigned)G, wave * 64 + lane_id());

    {
        Gemm g{DM, DM, DM}; SchedIn S{bx, (const char*)XG, (const char*)WIN};
        EpiIn E{B12, U, VT, rstd_x, ya};
        gemm_phase<EpiIn, SchedIn, true, true>(lds, g, S, E, wave);
    }
    xcd_barrier(gbar, xcc, xst, (unsigned)G, wave * 64 + lane_id());

    {
        const int NW = G >> 1;
        if (bx < NW) {
            { Gemm g{2048, 2048, SEQ / 2}; SchedPair S{bx, NW, (const char*)DFT, (const char*)B12};
              EpiDftZ E{PF};
              gemm_phase<EpiDftZ, SchedPair, true, true>(lds, g, S, E, wave); }
            { Gemm g{256, 256, 256}; SchedPost S{bx, NW, (const char*)PF, (const char*)GT};
              EpiPost E{MIX};
              gemm_phase<EpiPost, SchedPost, true, true>(lds, g, S, E, wave); }
            {
                const int ww = bx * 8 + wave, NWW = NW * 8, ln = lane_id(); LAS unsigned char* scr = lds + wave * 16384;
                constexpr int I_DN = (DFF / 64) * (DM / 64);
                for (int it = ww; it < I_DN; it += 2 * NWW) { const int it2 = it + NWW; const bool two = it2 < I_DN;
                    f32x4 va[16], vb[16];
                    tr_load(va, w_dn, DM, it, ln); if (two) tr_load(vb, w_dn, DM, it2, ln);
                    tr_store(va, DFF, DM, WDN, scr, it, ln); if (two) tr_store(vb, DFF, DM, WDN, scr, it2, ln); }
            }
        } else {
            const int hw = (bx - NW) * 8 + wave, NHW = (G - NW) * 8, ln = lane_id();
            for (int n = hw; n < NB * FW; n += NHW) {
                const int d = n & 127, g = (n >> 7) & 7; const unsigned gw2 = *(const unsigned*)(GT + (size_t)g * 65536 + (size_t)d * 256 + 2 * ln);
                const float y0 = ya[(n & ~127) + 2 * ln], y1 = ya[(n & ~127) + 2 * ln + 1];
                float t = __builtin_bit_cast(float, gw2 << 16) * y0 + __builtin_bit_cast(float, gw2 & 0xffff0000u) * y1;
                t = wave_sum(t);
                if (ln == 0) MIX[(size_t)((n >> 10) * SEQ + SEQ / 2) * DM + (n & 1023)] = (bf16_t)(cvt_pk_bf16(t, 0.f) & 0xffffu);
            }
    {
        const int w4 = wave & 3, sub = wave >> 2;
        for (int it = bx - NW; it < 512; it += G - NW) {
            const int ln = lane_id(), fr = ln & 15, fq = ln >> 4; const unsigned lo16 = (unsigned)ln * 16u;
            const int unit = it * 2 + sub, h = unit & 7, n = (unit >> 3) & 15, b = unit >> 7, tok0 = b * SEQ + n * 128;
            const bf16_t* vt = VT + (size_t)(((b * 16 + n) * 8 + h) * 128) * 128;
            const float* wsh = w_s + (size_t)h * 128 * 128;
            bf16x8 bfr[2][4][2];
#pragma unroll
            for (int ks = 0; ks < 2; ++ks) {
#pragma unroll
                for (int gp = 0; gp < 4; ++gp)
#pragma unroll
                    for (int nn = 0; nn < 2; ++nn) bfr[ks][gp][nn] = *(const bf16x8*)((const char*)vt + ((ks * 4 + gp) * 2 + nn) * 1024 + lo16);
            }
            f32x4 acc[2][4][2];
#pragma unroll
            for (int mi = 0; mi < 2; ++mi)
#pragma unroll
                for (int gp = 0; gp < 4; ++gp)
#pragma unroll
                    for (int nn = 0; nn < 2; ++nn) acc[mi][gp][nn] = (f32x4){0.f, 0.f, 0.f, 0.f};
            bf16x8 u8[2][4];
#pragma unroll
            for (int ks = 0; ks < 4; ++ks) {
                f32x4 wv[2][2];
#pragma unroll
                for (int mi = 0; mi < 2; ++mi) { const float* wp = wsh + (32 * w4 + 16 * mi + fr) * 128 + ks * 32 + fq * 8; wv[mi][0] = *(const f32x4*)wp; wv[mi][1] = *(const f32x4*)(wp + 4); }
                float ss[8];
#pragma unroll
                for (int j = 0; j < 8; ++j) ss[j] = 0.f;
#pragma unroll
                for (int gp = 0; gp < 4; ++gp)
#pragma unroll
                    for (int nn = 0; nn < 2; ++nn)
#pragma unroll
                        for (int j = 0; j < 8; ++j) { const float v = bf2f((unsigned short)bfr[ks & 1][gp][nn][j]); ss[j] += v * v; }
#pragma unroll
                for (int j = 0; j < 8; ++j) { float sv = ss[j];
                    sv += __builtin_bit_cast(float, __builtin_amdgcn_update_dpp(0, __builtin_bit_cast(int, sv), 0x128, 0xf, 0xf, false));
                    sv += __builtin_bit_cast(float, __builtin_amdgcn_update_dpp(0, __builtin_bit_cast(int, sv), 0x124, 0xf, 0xf, false));
                    sv += __builtin_bit_cast(float, __builtin_amdgcn_update_dpp(0, __builtin_bit_cast(int, sv), 0x122, 0xf, 0xf, false));
                    sv += __builtin_bit_cast(float, __builtin_amdgcn_update_dpp(0, __builtin_bit_cast(int, sv), 0x121, 0xf, 0xf, false));
                    ss[j] = __builtin_amdgcn_rsqf(sv * (1.0f / 128.0f) + EPS); }
                bf16x8 afr[2];
#pragma unroll
                for (int mi = 0; mi < 2; ++mi) { const f32x4 w0 = wv[mi][0], w1 = wv[mi][1];
                    u32x4 pk; pk.x = cvt_pk_bf16(w0[0] * ss[0], w0[1] * ss[1]); pk.y = cvt_pk_bf16(w0[2] * ss[2], w0[3] * ss[3]); pk.z = cvt_pk_bf16(w1[0] * ss[4], w1[1] * ss[5]); pk.w = cvt_pk_bf16(w1[2] * ss[6], w1[3] * ss[7]);
                    afr[mi] = __builtin_bit_cast(bf16x8, pk); }
#pragma unroll
                for (int mi = 0; mi < 2; ++mi)
#pragma unroll
                    for (int gp = 0; gp < 4; ++gp)
#pragma unroll
                        for (int nn = 0; nn < 2; ++nn) acc[mi][gp][nn] = __builtin_amdgcn_mfma_f32_16x16x32_bf16(bfr[ks & 1][gp][nn], afr[mi], acc[mi][gp][nn], 0, 0, 0);
                if (ks < 2) {
                    asm volatile("" ::: "memory");
#pragma unroll
                    for (int gp = 0; gp < 4; ++gp)
#pragma unroll
                        for (int nn = 0; nn < 2; ++nn) bfr[ks][gp][nn] = *(const bf16x8*)((const char*)vt + (((ks + 2) * 4 + gp) * 2 + nn) * 1024 + lo16);
                }
            }
            asm volatile("" ::: "memory");
#pragma unroll
            for (int mi = 0; mi < 2; ++mi)
#pragma unroll
                for (int gp = 0; gp < 4; ++gp) u8[mi][gp] = *(const bf16x8*)(U + (size_t)(tok0 + 32 * w4 + 16 * mi + fr) * FW + h * 128 + 32 * gp + 8 * fq);
#pragma unroll
            for (int mi = 0; mi < 2; ++mi) { const int p = 32 * w4 + 16 * mi + fr, tok = tok0 + p; const float bias = b_s[h * 128 + p];
#pragma unroll
                for (int gp = 0; gp < 4; ++gp) { const int d0 = 32 * gp + 8 * fq;
                    const f32x4 gv0 = *(const f32x4*)(g_v + h * 128 + d0), gv1 = *(const f32x4*)(g_v + h * 128 + d0 + 4);
                    f32x4 y0, y1;
                    f32x4 ua, ub;
#pragma unroll
                    for (int j = 0; j < 4; ++j) { ua[j] = bf2f((unsigned short)u8[mi][gp][j]); ub[j] = bf2f((unsigned short)u8[mi][gp][4 + j]); }
                    ua = gelu4(ua); ub = gelu4(ub);
#pragma unroll
                    for (int j = 0; j < 4; ++j) { y0[j] = ua[j] * (acc[mi][gp][0][j] * gv0[j] + bias); y1[j] = ub[j] * (acc[mi][gp][1][j] * gv1[j] + bias); }
                    *(u32x4*)(MIX + (size_t)tok * DM + FW + h * 128 + d0) = pack8(y0, y1); } }
        }
    }
            LAS unsigned char* scr = lds + wave * 16384;
            constexpr int I_UP = (DM / 64) * (DFF / 64);
            for (int it = hw; it < I_UP; it += 2 * NHW) {
                const int it2 = it + NHW; const bool two = it2 < I_UP;
                f32x4 va[16], vb[16];
                tr_load(va, w_up, DFF, it, ln); if (two) tr_load(vb, w_up, DFF, it2, ln);
                tr_store(va, DM, DFF, WUP, scr, it, ln); if (two) tr_store(vb, DM, DFF, WUP, scr, it2, ln);
            }
        }
    }
    xcd_barrier(gbar, xcc, xst, (unsigned)G, wave * 64 + lane_id());

    {
        Gemm g{DM, DM, DM}; SchedStd S; S.so.init(MT, DM, G, bx); S.A = (const char*)MIX; S.B = (const char*)WOUT; S.ta = (size_t)256 * DM * 2; S.tb = (size_t)256 * DM * 2;
        EpiOut E{XG, igmix, g_mlp, ss_h};
        gemm_phase<EpiOut, SchedStd, true, true>(lds, g, S, E, wave);
    }
    xcd_barrier(gbar, xcc, xst, (unsigned)G, wave * 64 + lane_id());

    {
        Gemm g{DM, DM, DM}; SchedStd S; S.so.init(MT, DFF, G, bx); S.A = (const char*)XG; S.B = (const char*)WUP; S.ta = (size_t)256 * DM * 2; S.tb = (size_t)256 * DM * 2;
        EpiUp E{ACT};
        gemm_phase<EpiUp, SchedStd, true, true>(lds, g, S, E, wave);
    }
    xcd_barrier(gbar, xcc, xst, (unsigned)G, wave * 64 + lane_id());

    if (G == 256) {
        Gemm g{64, DFF, DFF, 256 * 64 * 2, BK * 2}; SchedFinal S{bx, (const char*)ACT, (const char*)WDN};
        EpiFinal E{XG, igmlp, ss_h, ss_h2, pcnt, g_fin, out};
        gemm_phase<EpiFinal, SchedFinal, true, true>(lds, g, S, E, wave);
    } else {
    {
        Gemm g{64, DFF, DFF, 256 * 64 * 2, BK * 2}; SchedStd S; S.so.init(MT, DM, G, bx); S.A = (const char*)ACT; S.B = (const char*)WDN; S.ta = (size_t)256 * DFF * 2; S.tb = (size_t)256 * DFF * 2;
        EpiDown E{XG, igmlp, ss_h, ss_h2};
        gemm_phase<EpiDown, SchedStd, true, true>(lds, g, S, E, wave);
    }
    xcd_barrier(gbar, xcc, xst, (unsigned)G, wave * 64 + lane_id());

    {
        const int gw = bx * 8 + wave, NGW = G * 8, ln = lane_id();
        for (int m = 2 * gw; m < MT; m += 2 * NGW) {
            const u32x4* hrow = (const u32x4*)(XG + (size_t)m * DM) + ln; f32x4* orow = (f32x4*)(out + (size_t)m * DM) + 2 * ln; const f32x4* gr = (const f32x4*)g_fin + 2 * ln;
            u32x4 hv[2][4];
#pragma unroll
            for (int j = 0; j < 4; ++j) { hv[0][j] = hrow[64 * j]; hv[1][j] = hrow[256 + 64 * j]; }
            const float rs0 = 1.0f / sqrtf(ss_h2[m] * (1.0f / DM) + EPS), rs1 = 1.0f / sqrtf(ss_h2[m + 1] * (1.0f / DM) + EPS);
#pragma unroll
            for (int j = 0; j < 4; ++j) { const f32x4 g0 = gr[128 * j], g1 = gr[128 * j + 1];
#pragma unroll
                for (int rr = 0; rr < 2; ++rr) { const u32x4 h = hv[rr][j]; const float rs = rr ? rs1 : rs0; f32x4 v0, v1;
                    v0[0] = __builtin_bit_cast(float, h.x << 16); v0[1] = __builtin_bit_cast(float, h.x & 0xffff0000u); v0[2] = __builtin_bit_cast(float, h.y << 16); v0[3] = __builtin_bit_cast(float, h.y & 0xffff0000u);
                    v1[0] = __builtin_bit_cast(float, h.z << 16); v1[1] = __builtin_bit_cast(float, h.z & 0xffff0000u); v1[2] = __builtin_bit_cast(float, h.w << 16); v1[3] = __builtin_bit_cast(float, h.w & 0xffff0000u);
                    orow[rr * 512 + 128 * j] = v0 * rs * g0; orow[rr * 512 + 128 * j + 1] = v1 * rs * g1; } }
        }
    }
    }
}

extern "C" void kernel_launch(void* const* d_in, const int* in_sizes, int n_in, void* d_out, int out_size, void* d_ws, size_t ws_size, hipStream_t stream) {
    static int grid_blocks = 0;
    if (grid_blocks == 0) {
        if (n_in != 12 || in_sizes[0] != MT * DM || out_size != MT * DM || ws_size < WS_END) { fprintf(stderr, "kernel_launch: unexpected shapes (n_in %d, in0 %d, out %d, ws %zu)\n", n_in, n_in > 0 ? in_sizes[0] : -1, out_size, ws_size); grid_blocks = -1; return; }
        int dev = 0, cus = 0, per_cu = 0;
        hipGetDevice(&dev);
        hipDeviceGetAttribute(&cus, hipDeviceAttributeMultiprocessorCount, dev);
        if (hipFuncSetAttribute((const void*)fwd_megakernel, hipFuncAttributeMaxDynamicSharedMemorySize, LDS_BYTES) != hipSuccess) { fprintf(stderr, "kernel_launch: hipFuncSetAttribute failed\n"); grid_blocks = -1; return; }
        hipOccupancyMaxActiveBlocksPerMultiprocessor(&per_cu, (const void*)fwd_megakernel, 512, LDS_BYTES);
        if (per_cu < 1) { fprintf(stderr, "kernel_launch: occupancy query says %d blocks/CU\n", per_cu); per_cu = 1; }
        (void)hipGetLastError();
        grid_blocks = cus * per_cu;
        if (grid_blocks != 256) fprintf(stderr, "kernel_launch: the in-proj unit order assumes a 256-workgroup grid (got %d): output will be wrong\n", grid_blocks);
    }
    if (grid_blocks < 0) return;
    Args a{};
    for (int i = 0; i < 12; ++i) a.in[i] = (const float*)d_in[i];
    a.out = (float*)d_out; a.ws = (unsigned char*)d_ws;
    void* kargs[] = {&a};
    hipError_t e = hipLaunchCooperativeKernel((const void*)fwd_megakernel, dim3(grid_blocks), dim3(512), kargs, LDS_BYTES, stream);
    if (e != hipSuccess) fprintf(stderr, "cooperative launch failed: %s (grid %d)\n", hipGetErrorString(e), grid_blocks);
}
```
